# Optimizing an MI355X kernel written in HIP

```python
import math
import jax, jax.numpy as jnp
from jax import lax
import numpy as np

D_MODEL = 1024
BATCH = 8
SEQ = 4096
DEPTH = 1

D_HEAD = 64
ROPE_THETA = 10000.0
Q_BLOCK = 128
H_DIFF = 4
DIFF_V = 2 * D_HEAD
N_Q_SWA = 8
N_KV_SWA = 2
GQA = N_Q_SWA // N_KV_SWA
WINDOW = 128
MEM_LEN = 256
H_CROSS = 4
D_CROSS = D_MODEL // H_CROSS
N_GROUPS = 4
E_PER_GROUP = 8
N_EXPERTS = N_GROUPS * E_PER_GROUP
TOP_K_INNER = 2
D_FF_EXPERT = 512
EXPERT_BLOCK = 128
EPS = 1e-6

DQ_W = H_DIFF * 2 * D_HEAD
DK_W = H_DIFF * 2 * D_HEAD
DV_W = H_DIFF * DIFF_V
SQ_W = N_Q_SWA * D_HEAD
SK_W = N_KV_SWA * D_HEAD
SV_W = N_KV_SWA * D_HEAD
IN_W = DQ_W + DK_W + DV_W + SQ_W + SK_W + SV_W
SPLITS = [DQ_W, DQ_W + DK_W, DQ_W + DK_W + DV_W, DQ_W + DK_W + DV_W + SQ_W, DQ_W + DK_W + DV_W + SQ_W + SK_W]
MIX_OUT = H_DIFF * DIFF_V + N_Q_SWA * D_HEAD

kernel_name = "hybrid_diffattn_swa_sink_hmoe_block"


def rmsnorm(x, w):
    xf = x.astype(jnp.float32)
    y = xf * lax.rsqrt(jnp.mean(xf * xf, axis=-1, keepdims=True) + EPS)
    return (y * w.astype(jnp.float32)).astype(x.dtype)


def rope_tables(positions):
    inv_freq = jnp.exp(-math.log(ROPE_THETA) * jnp.arange(0, D_HEAD, 2, dtype=jnp.float32) / D_HEAD)
    ang = positions.astype(jnp.float32)[..., None] * inv_freq
    return jnp.cos(ang), jnp.sin(ang)


def rope(x, cos, sin):
    shp = cos.shape[:2] + (1,) * (x.ndim - 3) + cos.shape[-1:]
    c, s = cos.reshape(shp), sin.reshape(shp)
    xf = x.astype(jnp.float32)
    x1, x2 = xf[..., : D_HEAD // 2], xf[..., D_HEAD // 2:]
    return jnp.concatenate([x1 * c - x2 * s, x2 * c + x1 * s], axis=-1).astype(x.dtype)


def diff_attention(q, k, v, lam, subln_w, lambda_init):
    B, S = q.shape[0], q.shape[1]
    nb = S // Q_BLOCK
    scale = D_HEAD ** -0.5
    qb = q.reshape(B, nb, Q_BLOCK, H_DIFF, 2, D_HEAD).transpose(1, 0, 2, 3, 4, 5)
    starts = jnp.arange(nb, dtype=jnp.int32) * Q_BLOCK
    kpos = jnp.arange(S, dtype=jnp.int32)
    qoff = jnp.arange(Q_BLOCK, dtype=jnp.int32)

    def block(args):
        qblk, start = args
        s = jnp.einsum('bqhcd,bkhcd->bhcqk', qblk, k).astype(jnp.float32) * scale
        causal = kpos[None, :] <= (start + qoff)[:, None]
        s = jnp.where(causal, s, -jnp.inf)
        p = jax.nn.softmax(s, axis=-1)
        pd = p[:, :, 0] - lam * p[:, :, 1]
        return jnp.einsum('bhqk,bkhe->bqhe', pd.astype(v.dtype), v)

    o = lax.map(block, (qb, starts))
    o = o.transpose(1, 0, 2, 3, 4).reshape(B, S, H_DIFF, DIFF_V)
    o = rmsnorm(o, subln_w) * (1.0 - lambda_init)
    return o.reshape(B, S, H_DIFF * DIFF_V)


def sliding_window_sink_attention(q, k, v, sinks):
    B, S = q.shape[0], q.shape[1]
    nb = S // Q_BLOCK
    scale = D_HEAD ** -0.5
    qb = q.reshape(B, nb, Q_BLOCK, N_KV_SWA, GQA, D_HEAD)
    kb = k.reshape(B, nb, Q_BLOCK, N_KV_SWA, D_HEAD)
    vb = v.reshape(B, nb, Q_BLOCK, N_KV_SWA, D_HEAD)
    pad = ((0, 0), (1, 0), (0, 0), (0, 0), (0, 0))
    kk = jnp.concatenate([jnp.pad(kb, pad)[:, :-1], kb], axis=2)
    vv = jnp.concatenate([jnp.pad(vb, pad)[:, :-1], vb], axis=2)
    s = jnp.einsum('bnqhgd,bnkhd->bnhgqk', qb, kk).astype(jnp.float32) * scale
    qi = jnp.arange(Q_BLOCK)[:, None]
    ki = jnp.arange(2 * Q_BLOCK)[None, :]
    rel = Q_BLOCK + qi - ki
    band = (rel >= 0) & (rel < WINDOW)
    has_prev = jnp.arange(nb)[:, None, None] > 0
    valid = band[None] & (has_prev | (ki >= Q_BLOCK)[None])
    s = jnp.where(valid[None, :, None, None], s, -jnp.inf)
    sink = jnp.broadcast_to(sinks.astype(jnp.float32).reshape(N_KV_SWA, GQA)[None, None, :, :, None, None],
                            s.shape[:-1] + (1,))
    p = jax.nn.softmax(jnp.concatenate([s, sink], axis=-1), axis=-1)[..., :-1]
    o = jnp.einsum('bnhgqk,bnkhd->bnqhgd', p.astype(v.dtype), vv)
    return o.reshape(B, S, N_Q_SWA * D_HEAD)


def memory_cross_attention(hn, memn, wq, wkv, wo):
    B, S = hn.shape[0], hn.shape[1]
    M = memn.shape[1]
    q = (hn @ wq).reshape(B, S, H_CROSS, D_CROSS)
    kv = memn @ wkv
    k = kv[..., :D_MODEL].reshape(B, M, H_CROSS, D_CROSS)
    v = kv[..., D_MODEL:].reshape(B, M, H_CROSS, D_CROSS)
    s = jnp.einsum('bshd,bmhd->bhsm', q, k).astype(jnp.float32) * (D_CROSS ** -0.5)
    p = jax.nn.softmax(s, axis=-1)
    o = jnp.einsum('bhsm,bmhd->bshd', p.astype(v.dtype), v).reshape(B, S, D_MODEL)
    return o @ wo


def hierarchical_moe(t, w_group, b_group, w_expert, b_expert, w_gate, w_up, w_down):
    N, D = t.shape
    g_logits = (t @ w_group).astype(jnp.float32) + b_group.astype(jnp.float32)
    g_prob = jax.nn.softmax(g_logits, axis=-1)
    g_p, g_sel = lax.top_k(g_prob, 1)
    e_logits = ((t @ w_expert).astype(jnp.float32) + b_expert.astype(jnp.float32)).reshape(N, N_GROUPS, E_PER_GROUP)
    e_in_group = jnp.take_along_axis(e_logits, g_sel[:, :, None], axis=1)[:, 0]
    e_prob = jax.nn.softmax(e_in_group, axis=-1)
    e_p, e_idx = lax.top_k(e_prob, TOP_K_INNER)
    gates = g_p * (e_p / jnp.sum(e_p, axis=-1, keepdims=True))

    eid = (g_sel * E_PER_GROUP + e_idx).reshape(-1).astype(jnp.int32)
    gate = gates.reshape(-1)
    tok = jnp.repeat(jnp.arange(N, dtype=jnp.int32), TOP_K_INNER)
    A = N * TOP_K_INNER

    order = jnp.argsort(eid)
    e_s, tok_s, gate_s = eid[order], tok[order], gate[order]
    counts = jnp.zeros((N_EXPERTS,), jnp.int32).at[eid].add(1)
    starts = jnp.cumsum(counts) - counts
    padded = (counts + EXPERT_BLOCK - 1) // EXPERT_BLOCK * EXPERT_BLOCK
    pends = jnp.cumsum(padded)
    pstarts = pends - padded
    dest = pstarts[e_s] + (jnp.arange(A, dtype=jnp.int32) - starts[e_s])
    P = -(-(A + N_EXPERTS * (EXPERT_BLOCK - 1)) // EXPERT_BLOCK) * EXPERT_BLOCK
    nblk = P // EXPERT_BLOCK
    slot_tok = jnp.full((P,), N, jnp.int32).at[dest].set(tok_s)
    t_pad = jnp.concatenate([t, jnp.zeros((1, D), t.dtype)], axis=0)
    xs = t_pad[slot_tok].reshape(nblk, EXPERT_BLOCK, D)
    blk_start = jnp.arange(nblk, dtype=jnp.int32) * EXPERT_BLOCK
    blk_e = jnp.minimum(jnp.searchsorted(pends, blk_start, side='right'), N_EXPERTS - 1)

    def expert_rows(args):
        xb, e = args
        hdn = jax.nn.silu(xb @ w_gate[e]) * (xb @ w_up[e])
        return hdn @ w_down[e]

    ys = lax.map(expert_rows, (xs, blk_e)).reshape(P, D)
    y_assign = ys[dest].astype(jnp.float32) * gate_s[:, None]
    out = jax.ops.segment_sum(y_assign, tok_s, num_segments=N)
    return out.astype(t.dtype)


def setup_inputs(seed: int = 0) -> dict:
    key = jax.random.key(seed)
    ks = jax.random.split(key, 32)
    f32 = jnp.float32
    nrm = lambda k, shape, scale: jax.random.normal(k, shape, f32) * scale
    gain = lambda k, shape: 1.0 + 0.02 * jax.random.normal(k, shape, f32)
    L = DEPTH
    x = jax.random.normal(ks[0], (BATCH, SEQ, D_MODEL), f32)
    mem = jax.random.normal(ks[1], (BATCH, MEM_LEN, D_MODEL), f32)
    offsets = jax.random.randint(ks[2], (BATCH, 1), 0, 1024, dtype=jnp.int32)
    positions = (offsets + jnp.arange(SEQ, dtype=jnp.int32)[None, :]).astype(jnp.int32)
    return {
        "x": x,
        "mem": mem,
        "positions": positions,
        "ln_mix_w": gain(ks[3], (L, D_MODEL)),
        "w_in": nrm(ks[4], (L, D_MODEL, IN_W), D_MODEL ** -0.5),
        "lambda_q1": nrm(ks[5], (L, D_HEAD), 0.1),
        "lambda_k1": nrm(ks[6], (L, D_HEAD), 0.1),
        "lambda_q2": nrm(ks[7], (L, D_HEAD), 0.1),
        "lambda_k2": nrm(ks[8], (L, D_HEAD), 0.1),
        "subln_w": gain(ks[9], (L, DIFF_V)),
        "sinks": nrm(ks[10], (L, N_Q_SWA), 0.5),
        "w_out": nrm(ks[11], (L, MIX_OUT, D_MODEL), MIX_OUT ** -0.5),
        "ln_cross_w": gain(ks[12], (L, D_MODEL)),
        "ln_mem_w": gain(ks[13], (L, D_MODEL)),
        "wq_cross": nrm(ks[14], (L, D_MODEL, D_MODEL), D_MODEL ** -0.5),
        "wkv_cross": nrm(ks[15], (L, D_MODEL, 2 * D_MODEL), D_MODEL ** -0.5),
        "wo_cross": nrm(ks[16], (L, D_MODEL, D_MODEL), D_MODEL ** -0.5),
        "ln_moe_w": gain(ks[17], (L, D_MODEL)),
        "w_group": nrm(ks[18], (L, D_MODEL, N_GROUPS), D_MODEL ** -0.5),
        "b_group": nrm(ks[19], (L, N_GROUPS), 0.01),
        "w_expert": nrm(ks[20], (L, D_MODEL, N_EXPERTS), D_MODEL ** -0.5),
        "b_expert": nrm(ks[21], (L, N_EXPERTS), 0.01),
        "w_gate": nrm(ks[22], (L, N_EXPERTS, D_MODEL, D_FF_EXPERT), D_MODEL ** -0.5),
        "w_up": nrm(ks[23], (L, N_EXPERTS, D_MODEL, D_FF_EXPERT), D_MODEL ** -0.5),
        "w_down": nrm(ks[24], (L, N_EXPERTS, D_FF_EXPERT, D_MODEL), D_FF_EXPERT ** -0.5),
        "ln_final_w": gain(ks[25], (D_MODEL,)),
    }


def reference(x, mem, positions, ln_mix_w, w_in, lambda_q1, lambda_k1, lambda_q2, lambda_k2, subln_w, sinks,
              w_out, ln_cross_w, ln_mem_w, wq_cross, wkv_cross, wo_cross, ln_moe_w, w_group, b_group,
              w_expert, b_expert, w_gate, w_up, w_down, ln_final_w):
    B, S, D = x.shape
    cos, sin = rope_tables(positions)
    h = x
    for l in range(DEPTH):
        lambda_init = 0.8 - 0.6 * math.exp(-0.3 * l)
        a = rmsnorm(h, ln_mix_w[l])
        proj = a @ w_in[l]
        dq, dk, dv, sq, sk, sv = jnp.split(proj, SPLITS, axis=-1)
        dq = rope(dq.reshape(B, S, H_DIFF, 2, D_HEAD), cos, sin)
        dk = rope(dk.reshape(B, S, H_DIFF, 2, D_HEAD), cos, sin)
        dv = dv.reshape(B, S, H_DIFF, DIFF_V)
        lam = (jnp.exp(jnp.sum(lambda_q1[l].astype(jnp.float32) * lambda_k1[l].astype(jnp.float32)))
               - jnp.exp(jnp.sum(lambda_q2[l].astype(jnp.float32) * lambda_k2[l].astype(jnp.float32)))
               + lambda_init)
        o_diff = diff_attention(dq, dk, dv, lam, subln_w[l], lambda_init)
        sq = rope(sq.reshape(B, S, N_Q_SWA, D_HEAD), cos, sin)
        sk = rope(sk.reshape(B, S, N_KV_SWA, D_HEAD), cos, sin)
        sv = sv.reshape(B, S, N_KV_SWA, D_HEAD)
        o_swa = sliding_window_sink_attention(sq, sk, sv, sinks[l])
        h = h + jnp.concatenate([o_diff, o_swa], axis=-1) @ w_out[l]
        c = rmsnorm(h, ln_cross_w[l])
        m = rmsnorm(mem, ln_mem_w[l])
        h = h + memory_cross_attention(c, m, wq_cross[l], wkv_cross[l], wo_cross[l])
        f = rmsnorm(h, ln_moe_w[l]).reshape(B * S, D)
        h = h + hierarchical_moe(f, w_group[l], b_group[l], w_expert[l], b_expert[l],
                                 w_gate[l], w_up[l], w_down[l]).reshape(B, S, D)
    return rmsnorm(h, ln_final_w)
```

```cpp
#include <hip/hip_runtime.h>
#include <stdint.h>
#include <string.h>

typedef unsigned short bf16_t;

constexpr int BATCH = 8, SEQ = 4096, DM = 1024, NTOK = BATCH * SEQ, MEML = 256, NMEM = BATCH * MEML;
constexpr int INW = 2304, DQ0 = 0, DK0 = 512, DV0 = 1024, SQ0 = 1536, SK0 = 2048, SV0 = 2176;
constexpr int NEXP = 32, DFF = 512, PMAX = 73728;
constexpr float EPS = 1e-6f;
constexpr float LOG2E = 1.4426950408889634f;
constexpr float C2_SELF = 0.125f * LOG2E;
constexpr float C2_CROSS = 0.0625f * LOG2E;
constexpr float LAMBDA_INIT = 0.2f;

constexpr size_t ALIGN_UP(size_t x) { return (x + 255) & ~(size_t)255; }
constexpr size_t WS_CTL   = 0;
constexpr size_t CTL_BYTES = 65536;
constexpr size_t WS_RSTD0 = WS_CTL + CTL_BYTES;
constexpr size_t WS_RSTDM = WS_RSTD0 + (size_t)NTOK * 4;
constexpr size_t WS_RSTD1 = WS_RSTDM + (size_t)NMEM * 4;
constexpr size_t WS_RSTD2 = WS_RSTD1 + (size_t)NTOK * 4;
constexpr size_t WS_ROPE  = WS_RSTD2 + (size_t)NTOK * 4;
constexpr size_t WS_TOKE  = WS_ROPE + (size_t)NTOK * 32 * 8;
constexpr size_t WS_TOKI  = WS_TOKE + (size_t)NTOK * 2 * 4;
constexpr size_t WS_TOKG  = WS_TOKI + (size_t)NTOK * 2 * 4;
constexpr size_t WS_EXPL  = WS_TOKG + (size_t)NTOK * 2 * 4;
constexpr size_t WS_KVC   = WS_EXPL + (size_t)NEXP * NTOK * 4;
constexpr size_t WS_S0    = WS_KVC + (size_t)NMEM * 2048 * 2;
constexpr size_t S0_BYTES = (size_t)PMAX * DFF * 2 > (size_t)(NTOK + NMEM) * DM * 2 ? (size_t)PMAX * DFF * 2 : (size_t)(NTOK + NMEM) * DM * 2;
constexpr size_t WS_S1    = WS_S0 + S0_BYTES;
constexpr size_t S1_BYTES = (size_t)NTOK * INW * 2;
constexpr size_t WS_S2    = WS_S1 + S1_BYTES;
constexpr size_t WS_S3    = WS_S2 + (size_t)NTOK * DM * 2;
constexpr size_t WS_END   = WS_S3 + (size_t)NTOK * DM * 2;
static_assert((size_t)PMAX * DM * 2 <= S1_BYTES, "y must fit S1");
static_assert(WS_END <= (size_t)512 * 1024 * 1024, "workspace too big");
constexpr int CW_COUNTS = 12288;

__device__ __forceinline__ float bf2f(bf16_t v) { return __uint_as_float(((unsigned)v) << 16); }
__device__ __forceinline__ bf16_t f2bf(float f) { unsigned u = __float_as_uint(f); u += 0x7FFFu + ((u >> 16) & 1u); return (bf16_t)(u >> 16); }
__device__ __forceinline__ float wave_sum(float v) {
#pragma unroll
    for (int o = 32; o >= 1; o >>= 1) v += __shfl_xor(v, o);
    return v;
}
__device__ __forceinline__ float wave_max(float v) {
#pragma unroll
    for (int o = 32; o >= 1; o >>= 1) v = fmaxf(v, __shfl_xor(v, o));
    return v;
}

__device__ __forceinline__ int fresh_tid() { int t = threadIdx.x; asm volatile("" : "+v"(t)); return t; }

namespace pg8 {
#define PG8_LAS __attribute__((address_space(3)))
typedef unsigned short bf16_t;
typedef short bf16x8 __attribute__((ext_vector_type(8)));
typedef float f32x4 __attribute__((ext_vector_type(4)));
typedef unsigned u32x4 __attribute__((ext_vector_type(4)));
constexpr int BM = 256, BK = 64, HALF = 128, HTB = HALF * BK * 2  , STAGE_BYTES = 8 * HTB, NXCD = 8, WGM = 8;

__host__ __device__ __forceinline__ int lds_byte(int r, int c) { const int st = (r >> 4) * 2 + (c >> 5), rr = r & 15, cc = c & 31, ob = rr * 64 + cc * 2; return st * 1024 + (ob ^ (((ob >> 9) & 1) << 5)); }
__host__ __device__ __forceinline__ void stage_rc(int b, int& R, int& C) { const int st = b / 1024, sb = b % 1024, swz = sb ^ (((sb >> 9) & 1) << 5); R = (st >> 1) * 16 + swz / 64; C = (st & 1) * 32 + (swz % 64) / 2; }
__host__ __device__ __forceinline__ int perm32(int rho) { const int n = rho >> 4, i = rho & 15; return 8 * (i >> 2) + 4 * n + (i & 3); }

struct Unit { int pm, pn, ui; };
struct Gemm { const bf16_t* A; const bf16_t* Bt; int M, N, K; };

struct StaticOrder {
    static constexpr bool WT = false;
    int nM, nN, nwg, G, c;
    __host__ __device__ void init(int M, int N, int G_, int c_) { nM = M / BM; nN = N / BM; nwg = nM * nN; G = G_; c = c_; }
    __host__ __device__ __forceinline__ bool next(int i, Unit& u) const {
        const long L = (long)i * G + c; if (L >= nwg) return false;
        int wgid = (int)L; { const int q = nwg / NXCD, r = nwg % NXCD, xcd = wgid % NXCD, off = wgid / NXCD; wgid = (xcd < r ? xcd * (q + 1) : r * (q + 1) + (xcd - r) * q) + off; }
        const int nig = WGM * nN, gid = wgid / nig, fm = gid * WGM, gsz = (nM - fm) < WGM ? (nM - fm) : WGM;
        u.pm = fm + ((wgid % nig) % gsz); u.pn = (wgid % nig) / gsz; return true;
    }
    __device__ __forceinline__ void a_ready(const Unit&) const {}
    __device__ __forceinline__ void done(const Unit&) const {}
};

__device__ __forceinline__ unsigned cvt_pk_bf16(float lo, float hi) { unsigned r; asm volatile("v_cvt_pk_bf16_f32 %0, %1, %2" : "=v"(r) : "v"(lo), "v"(hi)); return r; }
typedef float f32x2 __attribute__((ext_vector_type(2)));

template <class Epi, class Sched, bool ALIGN_EPI = false, bool SP2 = false, bool GATHER = false, bool FP8 = false>
__device__ __forceinline__ void gemm_phase(PG8_LAS unsigned char* lds, const Gemm g, const Sched& S, const Epi& E) {
    const int tid = fresh_tid(), wid = __builtin_amdgcn_readfirstlane(tid >> 6), lane = tid & 63, wr = wid >> 2, wc = wid & 3, fr = lane & 15, fq = lane >> 4;
    const int K = g.K, nt = K / BK;
    unsigned voffA[2], voffB[2];
#pragma unroll
    for (int i = 0; i < 2; ++i) { int R, C; stage_rc(tid * 16 + i * 8192, R, C); const int Rb = Epi::PERM ? ((R & ~31) + perm32(R & 31)) : R;
        voffA[i] = (unsigned)(R * K + C) * 2u; voffB[i] = (unsigned)(Rb * K + C) * 2u; }
    const int pg8_sc7f = 0x7f7f7f7f;
    unsigned gC[2][2] = {{0u, 0u}, {0u, 0u}}, gN[2][2] = {{0u, 0u}, {0u, 0u}};
#define PG8_GOFF(dst, uu) do { _Pragma("unroll") for (int _i = 0; _i < 2; ++_i) { int _R, _C; stage_rc(tid * 16 + _i * 8192, _R, _C); \
        dst[0][_i] = (unsigned)S.arow(uu, _R) * (unsigned)(K * 2) + (unsigned)_C * 2u; dst[1][_i] = (unsigned)S.arow(uu, HALF + _R) * (unsigned)(K * 2) + (unsigned)_C * 2u; } } while (0)
    const size_t kstep = (size_t)(BK * 2);
    const size_t hstep = (size_t)HALF * K * 2;
    const size_t tstep = 2 * hstep;
    const unsigned ldsw = (unsigned)wid * 1024u;
    const int aoff = lds_byte(wr * 64 + fr, fq * 8), boff = lds_byte(wc * 32 + fr, fq * 8);
#define PG8_SA(b, h) (((b) * 2 + (h)) * HTB)
#define PG8_SB(b, h) ((4 + (b) * 2 + (h)) * HTB)
#define PG8_STAGE(bufoff, gbase, voff) do { _Pragma("unroll") for (int _i = 0; _i < 2; ++_i) \
        __builtin_amdgcn_global_load_lds((const unsigned*)((const char*)(gbase) + (voff)[_i]), (PG8_LAS unsigned*)(lds + (bufoff) + ldsw + _i * 8192), 16, 0, 0); } while (0)
#define PG8_STAGE_A(bufoff, gbase, h, nx) do { _Pragma("unroll") for (int _i = 0; _i < 2; ++_i) { \
        const unsigned _o = GATHER ? ((nx) ? gN[h][_i] : gC[h][_i]) : voffA[_i]; \
        __builtin_amdgcn_global_load_lds((const unsigned*)((const char*)(gbase) + (GATHER ? (size_t)0 : (size_t)(h) * hstep) + _o), (PG8_LAS unsigned*)(lds + (bufoff) + ldsw + _i * 8192), 16, 0, 0); } } while (0)
#define PG8_LDA(dst, b, h) do { _Pragma("unroll") for (int m = 0; m < 4; ++m) _Pragma("unroll") for (int k = 0; k < 2; ++k) dst[m][k] = *(const PG8_LAS bf16x8*)(lds + PG8_SA(b, h) + aoff + m * 2048 + k * 1024); } while (0)
#define PG8_LDB(dst, b, h) do { _Pragma("unroll") for (int n = 0; n < 2; ++n) _Pragma("unroll") for (int k = 0; k < 2; ++k) dst[n][k] = *(const PG8_LAS bf16x8*)(lds + PG8_SB(b, h) + boff + n * 2048 + k * 1024); } while (0)
#define PG8_MMA(ai, bj, At, Bt) do { __builtin_amdgcn_s_setprio(1); _Pragma("unroll") for (int m = 0; m < 4; ++m) _Pragma("unroll") for (int n = 0; n < 2; ++n) { \
        if constexpr (FP8) { typedef int v4i_ __attribute__((ext_vector_type(4))); typedef int v8i_ __attribute__((ext_vector_type(8))); \
            const v4i_ _b0 = __builtin_bit_cast(v4i_, Bt[n][0]), _b1 = __builtin_bit_cast(v4i_, Bt[n][1]), _a0 = __builtin_bit_cast(v4i_, At[m][0]), _a1 = __builtin_bit_cast(v4i_, At[m][1]); \
            const v8i_ _bb = __builtin_shufflevector(_b0, _b1, 0, 1, 2, 3, 4, 5, 6, 7), _aa = __builtin_shufflevector(_a0, _a1, 0, 1, 2, 3, 4, 5, 6, 7); \
            asm("v_mfma_scale_f32_16x16x128_f8f6f4 %0, %1, %2, %0, %3, %3 op_sel_hi:[0,0,0]" : "+v"(acc[ai][bj][m][n]) : "v"(_bb), "v"(_aa), "v"(pg8_sc7f)); } \
        else { _Pragma("unroll") for (int k = 0; k < 2; ++k) acc[ai][bj][m][n] = __builtin_amdgcn_mfma_f32_16x16x32_bf16(Bt[n][k], At[m][k], acc[ai][bj][m][n], 0, 0, 0); } } \
        __builtin_amdgcn_s_setprio(0); } while (0)
#define PG8_WAIT_V(n) asm volatile("s_waitcnt vmcnt(" #n ")" ::: "memory")
#define PG8_WAIT_L(n) asm volatile("s_waitcnt lgkmcnt(" #n ")" ::: "memory")
#define PG8_BAR __builtin_amdgcn_s_barrier()
#define PG8_SCHED __builtin_amdgcn_sched_barrier(0)
    Unit cur, nxt; int ui = 0;
    if (!S.next(0, cur)) return;
    f32x4 acc[2][2][4][2];
#pragma unroll
    for (int a = 0; a < 2; ++a)
#pragma unroll
        for (int b = 0; b < 2; ++b)
#pragma unroll
            for (int m = 0; m < 4; ++m)
#pragma unroll
                for (int n = 0; n < 2; ++n) acc[a][b][m][n] = (f32x4){0.f, 0.f, 0.f, 0.f};
    bf16x8 At[4][2], B0[2][2], B1[2][2];
    const char* cA = GATHER ? (const char*)g.A : (const char*)g.A + (size_t)cur.pm * tstep; const char* cB = (const char*)g.Bt + (size_t)cur.pn * tstep;
    if constexpr (GATHER) { PG8_GOFF(gC, cur); }
    S.a_ready(cur);
    if constexpr (SP2) {
        PG8_STAGE(PG8_SB(0, 0), cB, voffB); PG8_STAGE(PG8_SB(0, 1), cB + hstep, voffB); PG8_STAGE_A(PG8_SA(0, 0), cA, 0, false); PG8_STAGE_A(PG8_SA(0, 1), cA, 1, false);
        if (wr == 1) PG8_BAR;
        PG8_WAIT_V(2); PG8_BAR;
        PG8_STAGE(PG8_SB(1, 0), cB + kstep, voffB); PG8_STAGE_A(PG8_SA(1, 0), cA + kstep, 0, false); PG8_STAGE(PG8_SB(1, 1), cB + hstep + kstep, voffB);
        PG8_WAIT_V(6); PG8_BAR;
    } else {
        PG8_STAGE(PG8_SB(0, 0), cB, voffB); PG8_STAGE_A(PG8_SA(0, 0), cA, 0, false); PG8_STAGE(PG8_SB(0, 1), cB + hstep, voffB); PG8_STAGE_A(PG8_SA(0, 1), cA, 1, false);
        if (wr == 1) PG8_BAR;
        PG8_WAIT_V(4); PG8_BAR;
        PG8_STAGE(PG8_SB(1, 0), cB + kstep, voffB); PG8_STAGE_A(PG8_SA(1, 0), cA + kstep, 0, false); PG8_STAGE(PG8_SB(1, 1), cB + hstep + kstep, voffB);
        PG8_WAIT_V(6); PG8_BAR;
    }
    for (;;) {
        const bool has_next = S.next(ui + 1, nxt);
        const char* nA = GATHER ? cA : (has_next ? (const char*)g.A + (size_t)nxt.pm * tstep : cA); const char* nB = has_next ? (const char*)g.Bt + (size_t)nxt.pn * tstep : cB;
        for (int t = 0; t < nt; t += 2) {
            const bool last = (t == nt - 2);
            const char* a1 = cA + (size_t)(t + 1) * kstep;
            const char* a2 = last ? nA : cA + (size_t)(t + 2) * kstep; const char* b2 = last ? nB : cB + (size_t)(t + 2) * kstep;
            const char* a3 = a2 + kstep; const char* b3 = b2 + kstep;
            if (last && has_next) S.a_ready(nxt);
            if constexpr (GATHER) { if (last) { if (has_next) { PG8_GOFF(gN, nxt); } else { gN[0][0] = gC[0][0]; gN[0][1] = gC[0][1]; gN[1][0] = gC[1][0]; gN[1][1] = gC[1][1]; } } }
            if constexpr (SP2) {
            PG8_LDB(B0, 0, 0); PG8_LDB(B1, 0, 1); PG8_SCHED; PG8_LDA(At, 0, 0); PG8_STAGE_A(PG8_SA(1, 1), a1, 1, false);
            PG8_WAIT_V(8); PG8_WAIT_L(0); PG8_BAR; PG8_MMA(0, 0, At, B0); PG8_MMA(0, 1, At, B1); PG8_BAR; PG8_SCHED;
            PG8_LDA(At, 0, 1); PG8_STAGE(PG8_SB(0, 0), b2, voffB); PG8_STAGE(PG8_SB(0, 1), b2 + hstep, voffB); PG8_STAGE_A(PG8_SA(0, 0), a2, 0, last);
            PG8_WAIT_V(8); PG8_WAIT_L(0); PG8_BAR; PG8_MMA(1, 0, At, B0); PG8_MMA(1, 1, At, B1); PG8_BAR; PG8_SCHED;
            PG8_LDB(B0, 1, 0); PG8_LDB(B1, 1, 1); PG8_SCHED; PG8_LDA(At, 1, 0); PG8_STAGE_A(PG8_SA(0, 1), a2, 1, last);
            PG8_WAIT_V(8); PG8_WAIT_L(0); PG8_BAR; PG8_MMA(0, 0, At, B0); PG8_MMA(0, 1, At, B1); PG8_BAR; PG8_SCHED;
            PG8_LDA(At, 1, 1); PG8_STAGE(PG8_SB(1, 0), b3, voffB); PG8_STAGE(PG8_SB(1, 1), b3 + hstep, voffB); PG8_STAGE_A(PG8_SA(1, 0), a3, 0, last);
            PG8_WAIT_V(8); PG8_WAIT_L(0); PG8_BAR; PG8_MMA(1, 0, At, B0); PG8_MMA(1, 1, At, B1); PG8_BAR; PG8_SCHED;
            } else {
            PG8_LDB(B0, 0, 0); PG8_SCHED; PG8_LDA(At, 0, 0); PG8_STAGE_A(PG8_SA(1, 1), a1, 1, false);
            PG8_WAIT_L(8); PG8_BAR; PG8_WAIT_L(0); PG8_MMA(0, 0, At, B0); PG8_BAR; PG8_SCHED;
            PG8_LDB(B1, 0, 1); PG8_STAGE(PG8_SB(0, 0), b2, voffB);
            PG8_BAR; PG8_WAIT_L(0); PG8_MMA(0, 1, At, B1); PG8_BAR;
            PG8_LDA(At, 0, 1); PG8_STAGE_A(PG8_SA(0, 0), a2, 0, last);
            PG8_BAR; PG8_WAIT_L(0); PG8_MMA(1, 0, At, B0); PG8_BAR; PG8_SCHED;
            PG8_STAGE(PG8_SB(0, 1), b2 + hstep, voffB);
            PG8_WAIT_V(6); PG8_BAR; PG8_MMA(1, 1, At, B1); PG8_BAR;
            PG8_LDB(B0, 1, 0); PG8_SCHED; PG8_LDA(At, 1, 0); PG8_STAGE_A(PG8_SA(0, 1), a2, 1, last);
            PG8_WAIT_L(8); PG8_BAR; PG8_WAIT_L(0); PG8_MMA(0, 0, At, B0); PG8_BAR; PG8_SCHED;
            PG8_LDB(B1, 1, 1); PG8_STAGE(PG8_SB(1, 0), b3, voffB);
            PG8_BAR; PG8_WAIT_L(0); PG8_MMA(0, 1, At, B1); PG8_BAR;
            PG8_LDA(At, 1, 1); PG8_STAGE_A(PG8_SA(1, 0), a3, 0, last);
            PG8_BAR; PG8_WAIT_L(0); PG8_MMA(1, 0, At, B0); PG8_BAR; PG8_SCHED;
            PG8_STAGE(PG8_SB(1, 1), b3 + hstep, voffB);
            PG8_WAIT_V(6); PG8_BAR; PG8_MMA(1, 1, At, B1); PG8_BAR;
            }
        }
        if constexpr (ALIGN_EPI) { if (wr == 0) PG8_BAR; }
        if constexpr (FP8) asm volatile("s_nop 15\n\ts_nop 15" ::: "memory");
        if constexpr (!Epi::AFTER_DRAIN) { E(acc, cur, wr, wc, fr, fq); S.done(cur); }
        if (!has_next) break;
#pragma unroll
        for (int a = 0; a < 2; ++a)
#pragma unroll
            for (int b = 0; b < 2; ++b)
#pragma unroll
                for (int m = 0; m < 4; ++m)
#pragma unroll
                    for (int n = 0; n < 2; ++n) acc[a][b][m][n] = (f32x4){0.f, 0.f, 0.f, 0.f};
        cur = nxt; cA = nA; cB = nB; ++ui;
        if constexpr (GATHER) { gC[0][0] = gN[0][0]; gC[0][1] = gN[0][1]; gC[1][0] = gN[1][0]; gC[1][1] = gN[1][1]; }
        if constexpr (ALIGN_EPI) { if (wr == 1) PG8_BAR; }
    }
    PG8_WAIT_V(0);
    if constexpr (!ALIGN_EPI) { if (wr == 0) PG8_BAR; }
    PG8_BAR;
    if constexpr (Epi::AFTER_DRAIN) { E.fused(acc, cur, wr, wc, fr, fq, lds, wid, lane); S.done(cur); }
#undef PG8_SA
#undef PG8_SB
#undef PG8_STAGE
#undef PG8_STAGE_A
#undef PG8_GOFF
#undef PG8_LDA
#undef PG8_LDB
#undef PG8_MMA
#undef PG8_WAIT_V
#undef PG8_WAIT_L
#undef PG8_BAR
#undef PG8_SCHED
}


__device__ __forceinline__ void order_map(int L, int nM, int nN, int& pm, int& pn) {
    const int nwg = nM * nN; int wgid = L; { const int q = nwg / NXCD, r = nwg % NXCD, xcd = wgid % NXCD, off = wgid / NXCD; wgid = (xcd < r ? xcd * (q + 1) : r * (q + 1) + (xcd - r) * q) + off; }
    const int nig = WGM * nN, gid = wgid / nig, fm = gid * WGM, gsz = (nM - fm) < WGM ? (nM - fm) : WGM;
    pm = fm + ((wgid % nig) % gsz); pn = (wgid % nig) / gsz;
}
struct StaticOrderUi : StaticOrder {
    __device__ __forceinline__ bool next(int i, Unit& u) const { u.ui = i; return StaticOrder::next(i, u); }
};
struct InProjOrder {
    int G, c;
    __device__ __forceinline__ bool next(int i, Unit& u) const {
        const int L = i * G + c; u.ui = i;
        if (L < 1152) { order_map(L, 128, 9, u.pm, u.pn); return true; }
        if (L < 1152 + 64) { order_map(L - 1152, 8, 8, u.pm, u.pn); u.pm += 128; u.pn += 9; return true; }
        return false;
    }
    __device__ __forceinline__ void a_ready(const Unit&) const {}
    __device__ __forceinline__ void done(const Unit&) const {}
};
struct MoeOrder {
    int G, c, nP;
    const PG8_LAS int* pst;
    const PG8_LAS int* tokt;
    __device__ __forceinline__ bool next(int i, Unit& u) const {
        const int L = i * G + c; if (L >= nP * 4) return false;
        int sp, pnl; order_map(L, nP, 4, sp, pnl);
        int e = 0;
#pragma unroll 1
        for (int j = 1; j < 32; ++j) e += (pst[j] <= sp) ? 1 : 0;
        u.pm = sp; u.pn = e * 4 + pnl; u.ui = i; return true;
    }
    __device__ __forceinline__ int arow(const Unit& u, int R) const { return tokt[u.ui * 256 + R]; }
    __device__ __forceinline__ void a_ready(const Unit&) const {}
    __device__ __forceinline__ void done(const Unit&) const {}
};

typedef unsigned u32x4v __attribute__((ext_vector_type(4)));
__device__ __forceinline__ u32x4v pack8(const f32x4& a, const f32x4& b) { u32x4v w; w.x = cvt_pk_bf16(a[0], a[1]); w.y = cvt_pk_bf16(a[2], a[3]); w.z = cvt_pk_bf16(b[0], b[1]); w.w = cvt_pk_bf16(b[2], b[3]); return w; }
__device__ __forceinline__ void unpack8(const u32x4v w, f32x4& a, f32x4& b) {
    a[0] = __uint_as_float(w.x << 16); a[1] = __uint_as_float(w.x & 0xffff0000u); a[2] = __uint_as_float(w.y << 16); a[3] = __uint_as_float(w.y & 0xffff0000u);
    b[0] = __uint_as_float(w.z << 16); b[1] = __uint_as_float(w.z & 0xffff0000u); b[2] = __uint_as_float(w.w << 16); b[3] = __uint_as_float(w.w & 0xffff0000u);
}

#define E4M3_CLAMP(x) __builtin_amdgcn_fmed3f((x), -448.0f, 448.0f)
__device__ __forceinline__ uint2 pack8_fp8(const f32x4& a, const f32x4& b) {
    int lo = 0, hi = 0;
    lo = __builtin_amdgcn_cvt_pk_fp8_f32(E4M3_CLAMP(a[0]), E4M3_CLAMP(a[1]), lo, false); lo = __builtin_amdgcn_cvt_pk_fp8_f32(E4M3_CLAMP(a[2]), E4M3_CLAMP(a[3]), lo, true);
    hi = __builtin_amdgcn_cvt_pk_fp8_f32(E4M3_CLAMP(b[0]), E4M3_CLAMP(b[1]), hi, false); hi = __builtin_amdgcn_cvt_pk_fp8_f32(E4M3_CLAMP(b[2]), E4M3_CLAMP(b[3]), hi, true);
    return make_uint2((unsigned)lo, (unsigned)hi);
}
struct EpiInProj {
    static constexpr bool PERM = true, AFTER_DRAIN = false;
    bf16_t* projr; bf16_t* kvc; const PG8_LAS float* rst; const unsigned* tab;
    __device__ __forceinline__ void operator()(const f32x4 (&acc)[2][2][4][2], const Unit& u, int wr, int wc, int fr, int fq) const {
        const int rl0 = wr * 64 + fr, row0 = u.pm * BM + rl0, pn = u.pn;
        const PG8_LAS float* rsu = rst + u.ui * 256 + rl0;
        if (pn >= 9) {
            const int col0 = (pn - 9) * 256 + wc * 32 + 8 * fq;
#pragma unroll
            for (int ai = 0; ai < 2; ++ai)
#pragma unroll
                for (int m = 0; m < 4; ++m) { const int r = row0 - 32768 + ai * HALF + m * 16; const float rs = rsu[ai * HALF + m * 16];
#pragma unroll
                    for (int bj = 0; bj < 2; ++bj) *(u32x4v*)(kvc + (size_t)r * 2112 + col0 + bj * HALF) = pack8(acc[ai][bj][m][0] * rs, acc[ai][bj][m][1] * rs); }
        } else if (pn == 4 || pn == 5 || (pn == 8 && wc >= 2)) {
            const int c0 = (pn == 8) ? (2176 + (wc - 2) * 32 + 8 * fq) : (1024 + (pn - 4) * 256 + wc * 32 + 8 * fq), cstep = (pn == 8) ? 64 : 128;
#pragma unroll
            for (int ai = 0; ai < 2; ++ai)
#pragma unroll
                for (int m = 0; m < 4; ++m) { const int r = row0 + ai * HALF + m * 16; const float rs = rsu[ai * HALF + m * 16];
#pragma unroll
                    for (int bj = 0; bj < 2; ++bj) *(u32x4v*)(projr + (size_t)r * 2304 + c0 + bj * cstep) = pack8(acc[ai][bj][m][0] * rs, acc[ai][bj][m][1] * rs); }
        } else {
            int cb; float sc = 1.0f;
            if (pn < 2) { cb = pn * 256; sc = 0.125f * 1.4426950408889634f; } else if (pn < 4) { cb = 512 + (pn - 2) * 256; } else if (pn < 8) { cb = 1536 + (pn - 6) * 256; sc = 0.125f * 1.4426950408889634f; } else { cb = 2048; }
            const int c0 = cb + wc * 64 + 8 * fq;
#pragma unroll
            for (int ai = 0; ai < 2; ++ai) {
                u32x4v tw[4][2];
#pragma unroll
                for (int m = 0; m < 4; ++m) { const u32x4v* tp = (const u32x4v*)(tab + (size_t)(row0 + ai * HALF + m * 16) * 32 + 8 * fq); tw[m][0] = tp[0]; tw[m][1] = tp[1]; }
#pragma unroll
                for (int m = 0; m < 4; ++m) { const int r = row0 + ai * HALF + m * 16; const float rs = rsu[ai * HALF + m * 16] * sc;
                    const u32x4v ta = tw[m][0], tb = tw[m][1];
                    const f32x4 cA = {__uint_as_float(ta.x << 16), __uint_as_float(ta.y << 16), __uint_as_float(ta.z << 16), __uint_as_float(ta.w << 16)};
                    const f32x4 sA = {__uint_as_float(ta.x & 0xffff0000u), __uint_as_float(ta.y & 0xffff0000u), __uint_as_float(ta.z & 0xffff0000u), __uint_as_float(ta.w & 0xffff0000u)};
                    const f32x4 cB = {__uint_as_float(tb.x << 16), __uint_as_float(tb.y << 16), __uint_as_float(tb.z << 16), __uint_as_float(tb.w << 16)};
                    const f32x4 sB = {__uint_as_float(tb.x & 0xffff0000u), __uint_as_float(tb.y & 0xffff0000u), __uint_as_float(tb.z & 0xffff0000u), __uint_as_float(tb.w & 0xffff0000u)};
                    const f32x4 x1a = acc[ai][0][m][0] * rs, x1b = acc[ai][0][m][1] * rs, x2a = acc[ai][1][m][0] * rs, x2b = acc[ai][1][m][1] * rs;
                    *(u32x4v*)(projr + (size_t)r * 2304 + c0) = pack8(x1a * cA - x2a * sA, x1b * cB - x2b * sB);
                    *(u32x4v*)(projr + (size_t)r * 2304 + c0 + 32) = pack8(x2a * cA + x1a * sA, x2b * cB + x1b * sB); }
            }
        }
    }
};
struct EpiRes {
    static constexpr bool PERM = true, AFTER_DRAIN = false;
    const bf16_t* res; bf16_t* out; float* ssp; unsigned char* out8; float asc;
    __device__ __forceinline__ void operator()(const f32x4 (&acc)[2][2][4][2], const Unit& u, int wr, int wc, int fr, int fq) const {
        const int row0 = u.pm * BM + wr * 64 + fr, col0 = u.pn * BM + wc * 32 + 8 * fq;
        u32x4v rv[4][2], ov[4][2]; uint2 o8[4][2]; float sv[4];
#define ER_LOAD(ai) do { _Pragma("unroll") for (int m = 0; m < 4; ++m) _Pragma("unroll") for (int bj = 0; bj < 2; ++bj) rv[m][bj] = *(const u32x4v*)(res + (size_t)(row0 + (ai) * HALF + m * 16) * 1024 + col0 + bj * HALF); } while (0)
#define ER_CALC(ai) do { _Pragma("unroll") for (int m = 0; m < 4; ++m) { float ss = 0.f; \
            _Pragma("unroll") for (int bj = 0; bj < 2; ++bj) { f32x4 ra, rb; unpack8(rv[m][bj], ra, rb); const f32x4 va = acc[ai][bj][m][0] * asc + ra, vb = acc[ai][bj][m][1] * asc + rb; \
                ss += (va[0] * va[0] + va[1] * va[1]) + (va[2] * va[2] + va[3] * va[3]) + (vb[0] * vb[0] + vb[1] * vb[1]) + (vb[2] * vb[2] + vb[3] * vb[3]); ov[m][bj] = pack8(va, vb); if (out8) o8[m][bj] = pack8_fp8(va, vb); } \
            ss += __shfl_xor(ss, 16); ss += __shfl_xor(ss, 32); sv[m] = ss; } } while (0)
#define ER_STORE(ai) do { _Pragma("unroll") for (int m = 0; m < 4; ++m) { const int r = row0 + (ai) * HALF + m * 16; \
            _Pragma("unroll") for (int bj = 0; bj < 2; ++bj) { *(u32x4v*)(out + (size_t)r * 1024 + col0 + bj * HALF) = ov[m][bj]; if (out8) *(uint2*)(out8 + (size_t)r * 1024 + col0 + bj * HALF) = o8[m][bj]; } \
            if (fq == 0) ssp[(size_t)r * 16 + u.pn * 4 + wc] = sv[m]; } } while (0)
        ER_LOAD(0); ER_CALC(0); ER_LOAD(1); ER_STORE(0); ER_CALC(1); ER_STORE(1);
#undef ER_LOAD
#undef ER_CALC
#undef ER_STORE
    }
};
__device__ __forceinline__ float rstd_from_ssp(const float* ssp, int r) {
    const f32x4* p = (const f32x4*)(ssp + (size_t)r * 16); const f32x4 a = p[0], b = p[1], c = p[2], d = p[3];
    const float s = ((a[0] + a[1]) + (a[2] + a[3])) + ((b[0] + b[1]) + (b[2] + b[3])) + ((c[0] + c[1]) + (c[2] + c[3])) + ((d[0] + d[1]) + (d[2] + d[3]));
    return rsqrtf(s * (1.0f / 1024.0f) + 1e-6f);
}
struct EpiScale {
    static constexpr bool PERM = true, AFTER_DRAIN = false;
    bf16_t* out; const PG8_LAS float* rst;
    __device__ __forceinline__ void operator()(const f32x4 (&acc)[2][2][4][2], const Unit& u, int wr, int wc, int fr, int fq) const {
        const int rl0 = wr * 64 + fr, row0 = u.pm * BM + rl0, col0 = u.pn * BM + wc * 32 + 8 * fq;
#pragma unroll
        for (int ai = 0; ai < 2; ++ai)
#pragma unroll
            for (int m = 0; m < 4; ++m) { const int r = row0 + ai * HALF + m * 16; const float rs = rst[u.ui * 256 + rl0 + ai * HALF + m * 16];
#pragma unroll
                for (int bj = 0; bj < 2; ++bj) *(u32x4v*)(out + (size_t)r * 1024 + col0 + bj * HALF) = pack8(acc[ai][bj][m][0] * rs, acc[ai][bj][m][1] * rs); }
    }
};
struct EpiGateUp {
    static constexpr bool PERM = true, AFTER_DRAIN = false;
    unsigned char* hdn; const PG8_LAS float* rst;
    __device__ __forceinline__ void operator()(const f32x4 (&acc)[2][2][4][2], const Unit& u, int wr, int wc, int fr, int fq) const {
        const int rl0 = wr * 64 + fr, col0 = (u.pn & 3) * 128 + wc * 32 + 8 * fq;
#pragma unroll
        for (int ai = 0; ai < 2; ++ai)
#pragma unroll
            for (int m = 0; m < 4; ++m) { const int rl = rl0 + ai * HALF + m * 16; const float rs = rst[u.ui * 256 + rl] * (1.0f / 64.0f);
                f32x4 h[2];
#pragma unroll
                for (int n = 0; n < 2; ++n) { const f32x4 g = acc[ai][0][m][n] * rs, up = acc[ai][1][m][n] * rs;
#pragma unroll
                    for (int j = 0; j < 4; ++j) h[n][j] = g[j] * __builtin_amdgcn_rcpf(1.0f + __builtin_amdgcn_exp2f(-1.4426950408889634f * g[j])) * up[j]; }
                *(uint2*)(hdn + (size_t)(u.pm * BM + rl) * 512 + col0) = pack8_fp8(h[0] * 8.0f, h[1] * 8.0f); }
    }
};
struct EpiDown {
    static constexpr bool PERM = true, AFTER_DRAIN = false;
    unsigned char* y;
    __device__ __forceinline__ void operator()(const f32x4 (&acc)[2][2][4][2], const Unit& u, int wr, int wc, int fr, int fq) const {
        const int row0 = u.pm * BM + wr * 64 + fr, col0 = (u.pn & 3) * BM + wc * 32 + 8 * fq;
#pragma unroll
        for (int ai = 0; ai < 2; ++ai)
#pragma unroll
            for (int m = 0; m < 4; ++m) { const int r = row0 + ai * HALF + m * 16;
#pragma unroll
                for (int bj = 0; bj < 2; ++bj) *(uint2*)(y + (size_t)r * 1024 + col0 + bj * HALF) = pack8_fp8(acc[ai][bj][m][0] * (1.0f / 16.0f), acc[ai][bj][m][1] * (1.0f / 16.0f)); }
    }
};
}


namespace att {
#define ALAS __attribute__((address_space(3)))
typedef short bf16x8 __attribute__((ext_vector_type(8)));
typedef short s16x4 __attribute__((ext_vector_type(4)));
typedef float f32x16 __attribute__((ext_vector_type(16)));
typedef unsigned u32x4 __attribute__((ext_vector_type(4)));
typedef float f32x2_t __attribute__((ext_vector_type(2)));
typedef __bf16 bf16x2_t __attribute__((ext_vector_type(2)));
typedef short v4i16_t __attribute__((ext_vector_type(4)));
__device__ __forceinline__ unsigned cvtpk(float lo, float hi) { f32x2_t v = {lo, hi}; bf16x2_t b = __builtin_convertvector(v, bf16x2_t); return __builtin_bit_cast(unsigned, b); }
__device__ __forceinline__ s16x4 vtr(const ALAS unsigned char* p) { return __builtin_bit_cast(s16x4, __builtin_amdgcn_ds_read_tr16_b64_v4i16((ALAS v4i16_t*)p)); }
__device__ __forceinline__ int crow(int r, int hi) { return (r & 3) + 8 * (r >> 2) + 4 * hi; }
__device__ __forceinline__ float amax3(float a, float b, float c) { float r; asm("v_max3_f32 %0, %1, %2, %3" : "=v"(r) : "v"(a), "v"(b), "v"(c)); return r; }
__device__ __forceinline__ float amax2(float a, float b) { float r; asm("v_max_f32_e32 %0, %1, %2" : "=v"(r) : "v"(a), "v"(b)); return r; }
__device__ __forceinline__ float xhalf_max(float x) { const auto rr = __builtin_amdgcn_permlane32_swap(__float_as_uint(x), __float_as_uint(x), false, false); return fmaxf(__uint_as_float(rr[0]), __uint_as_float(rr[1])); }
__device__ __forceinline__ float xhalf_sum(float x) { const auto rr = __builtin_amdgcn_permlane32_swap(__float_as_uint(x), __float_as_uint(x), false, false); return __uint_as_float(rr[0]) + __uint_as_float(rr[1]); }
template <int K> __device__ __forceinline__ float swz_xor(float x) { return __uint_as_float((unsigned)__builtin_amdgcn_ds_swizzle((int)__float_as_uint(x), (K << 10) | 0x1f)); }
__device__ __forceinline__ float aadd(float a, float b) { float r; asm("v_add_f32_e32 %0, %1, %2" : "=v"(r) : "v"(a), "v"(b)); return r; }
#define CROWC(r) (((r) & 3) + 8 * ((r) >> 2))
constexpr int SCR_OFF = 66560;
constexpr float THR = 8.0f;

}


namespace att {
__device__ __forceinline__ void diff_unit(ALAS unsigned char* lds, const bf16_t* __restrict__ projr, bf16_t* __restrict__ ocat, int b, int hh, int qb, float lam, const float* __restrict__ subln_w) {
    constexpr int KBB = 16384, VBB = 16384, VOFF = 32768, NDB = 4;
    const int tid = fresh_tid(), lane = tid & 63;
    const int r32 = lane & 31, hi = lane >> 5, w = __builtin_amdgcn_readfirstlane(tid >> 6);
    const int comp = w >> 2, qsub = w & 3;
    const int q0 = qb * 128 + qsub * 32;
    const size_t rowbase = (size_t)b * SEQ;
    const int t1 = 2 * qb + 2;
    bf16x8 qf[4];
#pragma unroll
    for (int d0 = 0; d0 < 4; ++d0) qf[d0] = *(const bf16x8*)(projr + (rowbase + q0 + r32) * INW + DQ0 + hh * 128 + comp * 64 + 16 * d0 + 8 * hi);
    const char* ksrc = (const char*)(projr + rowbase * INW + DK0 + hh * 128 + w * 8);
    const char* vsrc = (const char*)(projr + (rowbase + (w & 3) * 16) * INW + DV0 + hh * 128 + (w >> 2) * 32);
#define DF_KOFF ((unsigned)lane * (INW * 2))
#define DF_VOFF ((unsigned)(lane >> 2) * (INW * 2) + (unsigned)(lane & 3) * 16)
#define DF_DMAK(t) do { const char* _s = ksrc + (size_t)(t) * (64 * INW * 2); ALAS unsigned* _d = (ALAS unsigned*)(lds + ((t) & 1) * KBB + w * 1024); \
        __builtin_amdgcn_global_load_lds((const unsigned*)(_s + DF_KOFF), _d, 16, 0, 0); __builtin_amdgcn_global_load_lds((const unsigned*)(_s + 128 + DF_KOFF), _d + 2048, 16, 0, 0); } while (0)
#define DF_DMAV(t) do { const char* _s = vsrc + (size_t)(t) * (64 * INW * 2); ALAS unsigned* _d = (ALAS unsigned*)(lds + VOFF + ((t) & 1) * VBB + w * 1024); \
        __builtin_amdgcn_global_load_lds((const unsigned*)(_s + DF_VOFF), _d, 16, 0, 0); __builtin_amdgcn_global_load_lds((const unsigned*)(_s + 128 + DF_VOFF), _d + 2048, 16, 0, 0); } while (0)
    ALAS float* scr = (ALAS float*)(lds + SCR_OFF + w * 256);
    float m = 0.f, l = 0.f;
    f32x16 negm = f32x16{};
    f32x16 o[NDB];
#pragma unroll
    for (int d = 0; d < NDB; ++d) o[d] = f32x16{};
    const int kfrag = comp * 8192 + hi * 1024 + r32 * 16;
    const int vfrag = VOFF + ((lane >> 4) & 1) * 32 + (lane & 3) * 8 + (4 * hi + ((lane & 15) >> 2)) * 64;
#define DF_SBAR() __builtin_amdgcn_sched_barrier(0)
#define DF_QK1(S0, S1, t, d0) do { const ALAS unsigned char* _kb = lds + ((t) & 1) * KBB + kfrag + (d0) * 2048; const bf16x8 _k0 = *(const ALAS bf16x8*)(_kb), _k1 = *(const ALAS bf16x8*)(_kb + 512); \
        S0 = __builtin_amdgcn_mfma_f32_32x32x16_bf16(_k0, qf[d0], (d0) == 0 ? negm : S0, 0, 0, 0); S1 = __builtin_amdgcn_mfma_f32_32x32x16_bf16(_k1, qf[d0], (d0) == 0 ? negm : S1, 0, 0, 0); } while (0)
#define DF_PV1(PW, t, d) do { const ALAS unsigned char* _vb = lds + ((t) & 1) * VBB + vfrag + (d) * 4096; \
        _Pragma("unroll") for (int ks = 0; ks < 4; ++ks) { const s16x4 _lo = vtr(_vb + ks * 1024), _hi = vtr(_vb + ks * 1024 + 512); \
            const bf16x8 _vf = (bf16x8){_lo[0], _lo[1], _lo[2], _lo[3], _hi[0], _hi[1], _hi[2], _hi[3]}; \
            o[d] = __builtin_amdgcn_mfma_f32_32x32x16_bf16(__builtin_bit_cast(bf16x8, PW[ks]), _vf, o[d], 0, 0, 0); } } while (0)
#define DF_SM1(C0, C1, PW, i) do { C0[2 * (i)] = __builtin_amdgcn_exp2f(C0[2 * (i)]); C0[2 * (i) + 1] = __builtin_amdgcn_exp2f(C0[2 * (i) + 1]); \
        C1[2 * (i)] = __builtin_amdgcn_exp2f(C1[2 * (i)]); C1[2 * (i) + 1] = __builtin_amdgcn_exp2f(C1[2 * (i) + 1]); \
        lsum = aadd(lsum, aadd(aadd(C0[2 * (i)], C0[2 * (i) + 1]), aadd(C1[2 * (i)], C1[2 * (i) + 1]))); \
        PW[(i) >> 2][(i) & 3] = cvtpk(C0[2 * (i)], C0[2 * (i) + 1]); PW[2 + ((i) >> 2)][(i) & 3] = cvtpk(C1[2 * (i)], C1[2 * (i) + 1]); } while (0)
#define DF_QK(S0, S1, t) do { DF_SBAR(); DF_QK1(S0, S1, t, 0); DF_SBAR(); DF_QK1(S0, S1, t, 1); DF_SBAR(); DF_QK1(S0, S1, t, 2); DF_SBAR(); DF_QK1(S0, S1, t, 3); DF_SBAR(); } while (0)
#define DF_PV(PW, t) do { DF_SBAR(); DF_PV1(PW, t, 0); DF_SBAR(); DF_PV1(PW, t, 1); DF_SBAR(); DF_PV1(PW, t, 2); DF_SBAR(); DF_PV1(PW, t, 3); DF_SBAR(); } while (0)
#define DF_MAX(C0, C1, mx) do { mx = fmaxf(C0[0], C1[0]); _Pragma("unroll") for (int r = 1; r < 16; ++r) mx = fmaxf(mx, fmaxf(C0[r], C1[r])); mx = xhalf_max(mx); } while (0)
#define DF_RESCALE(C0, C1, dl) do { const float _dl = (dl), _al = __builtin_amdgcn_exp2f(-_dl); m += _dl; l *= _al; scr[r32] = _al; \
        _Pragma("unroll") for (int r = 0; r < 16; ++r) { const float _a = scr[4 * hi + CROWC(r)]; _Pragma("unroll") for (int d = 0; d < NDB; ++d) o[d][r] *= _a; } \
        _Pragma("unroll") for (int r = 0; r < 16; ++r) { C0[r] -= _dl; C1[r] -= _dl; negm[r] = -m; } } while (0)
#define DF_SOFTMAX(C0, C1, PW) do { float _ls = 0.f; \
        _Pragma("unroll") for (int r = 0; r < 16; ++r) { C0[r] = __builtin_amdgcn_exp2f(C0[r]); C1[r] = __builtin_amdgcn_exp2f(C1[r]); _ls += C0[r] + C1[r]; } \
        l += _ls; \
        _Pragma("unroll") for (int s = 0; s < 2; ++s) { \
            PW[s]     = (u32x4){cvtpk(C0[8 * s], C0[8 * s + 1]), cvtpk(C0[8 * s + 2], C0[8 * s + 3]), cvtpk(C0[8 * s + 4], C0[8 * s + 5]), cvtpk(C0[8 * s + 6], C0[8 * s + 7])}; \
            PW[2 + s] = (u32x4){cvtpk(C1[8 * s], C1[8 * s + 1]), cvtpk(C1[8 * s + 2], C1[8 * s + 3]), cvtpk(C1[8 * s + 4], C1[8 * s + 5]), cvtpk(C1[8 * s + 6], C1[8 * s + 7])}; } } while (0)
#define DF_KLD(F, t, d0) do { const ALAS unsigned char* _kb = lds + ((t) & 1) * KBB + kfrag + (d0) * 2048; F[0] = *(const ALAS bf16x8*)(_kb); F[1] = *(const ALAS bf16x8*)(_kb + 512); } while (0)
#define DF_VLD(F, t, d, kp) do { const ALAS unsigned char* _vb = lds + ((t) & 1) * VBB + vfrag + (d) * 4096 + (kp) * 2048; \
        _Pragma("unroll") for (int k2 = 0; k2 < 2; ++k2) { const s16x4 _lo = vtr(_vb + k2 * 1024), _hi = vtr(_vb + k2 * 1024 + 512); F[k2] = (bf16x8){_lo[0], _lo[1], _lo[2], _lo[3], _hi[0], _hi[1], _hi[2], _hi[3]}; } } while (0)
#define DF_QKM(S0, S1, F, d0) do { S0 = __builtin_amdgcn_mfma_f32_32x32x16_bf16(F[0], qf[d0], (d0) == 0 ? negm : S0, 0, 0, 0); S1 = __builtin_amdgcn_mfma_f32_32x32x16_bf16(F[1], qf[d0], (d0) == 0 ? negm : S1, 0, 0, 0); } while (0)
#define DF_PVM(PW, F, d, kp) do { o[d] = __builtin_amdgcn_mfma_f32_32x32x16_bf16(__builtin_bit_cast(bf16x8, PW[2 * (kp)]), F[0], o[d], 0, 0, 0); \
        o[d] = __builtin_amdgcn_mfma_f32_32x32x16_bf16(__builtin_bit_cast(bf16x8, PW[2 * (kp) + 1]), F[1], o[d], 0, 0, 0); } while (0)
#define DF_MAX8(mx, S, b0) amax3(amax3(amax3(amax3(mx, S[b0], S[b0 + 1]), S[b0 + 2], S[b0 + 3]), S[b0 + 4], S[b0 + 5]), S[b0 + 6], S[b0 + 7])
#define DF_STEP_FAST(C0, C1, N0, N1, PWO, PWN, t) do { \
        DF_DMAK((t) + 2); DF_DMAV(t); \
        bf16x8 fa[2], fb[2]; \
        DF_KLD(fa, (t) + 1, 0); \
        if (__any(mxc > THR)) { DF_PV(PWO, (t) - 1); PWO[0] = (u32x4){0u, 0u, 0u, 0u}; PWO[1] = PWO[0]; PWO[2] = PWO[0]; PWO[3] = PWO[0]; DF_RESCALE(C0, C1, fmaxf(mxc, 0.f)); } \
        float lsum = 0.f, mxa; DF_SBAR(); \
        DF_KLD(fb, (t) + 1, 1); DF_QKM(N0, N1, fa, 0); DF_SM1(C0, C1, PWN, 0); DF_SBAR(); \
        DF_KLD(fa, (t) + 1, 2); DF_QKM(N0, N1, fb, 1); DF_SM1(C0, C1, PWN, 1); DF_SBAR(); \
        DF_KLD(fb, (t) + 1, 3); DF_QKM(N0, N1, fa, 2); DF_SM1(C0, C1, PWN, 2); DF_SBAR(); \
        DF_VLD(fa, (t) - 1, 0, 0); DF_QKM(N0, N1, fb, 3); DF_SM1(C0, C1, PWN, 3); DF_SBAR(); \
        DF_VLD(fb, (t) - 1, 0, 1); DF_PVM(PWO, fa, 0, 0); DF_SM1(C0, C1, PWN, 4); DF_SBAR(); \
        DF_VLD(fa, (t) - 1, 1, 0); DF_PVM(PWO, fb, 0, 1); DF_SM1(C0, C1, PWN, 5); DF_SBAR(); \
        DF_VLD(fb, (t) - 1, 1, 1); DF_PVM(PWO, fa, 1, 0); DF_SM1(C0, C1, PWN, 6); DF_SBAR(); \
        DF_VLD(fa, (t) - 1, 2, 0); DF_PVM(PWO, fb, 1, 1); DF_SM1(C0, C1, PWN, 7); DF_SBAR(); \
        DF_VLD(fb, (t) - 1, 2, 1); DF_PVM(PWO, fa, 2, 0); mxa = DF_MAX8(N0[0], N0, 0); DF_SBAR(); \
        DF_VLD(fa, (t) - 1, 3, 0); DF_PVM(PWO, fb, 2, 1); mxa = DF_MAX8(mxa, N1, 0); DF_SBAR(); \
        DF_VLD(fb, (t) - 1, 3, 1); DF_PVM(PWO, fa, 3, 0); mxa = DF_MAX8(mxa, N0, 8); DF_SBAR(); \
        DF_PVM(PWO, fb, 3, 1); mxa = DF_MAX8(mxa, N1, 8); mxc = xhalf_max(mxa); DF_SBAR(); \
        l += lsum; \
        __syncthreads(); } while (0)
#define DF_STEP_GEN(C0, C1, N0, N1, PWO, PWN, t) do { \
        if ((t) + 2 < t1) DF_DMAK((t) + 2); \
        DF_DMAV(t); \
        const int _kv0 = (t) * 64; const bool _act = _kv0 <= q0 + 31, _actn = ((t) + 1 < t1) && (_kv0 + 64 <= q0 + 31); \
        if (_act) { \
            if (_kv0 + 63 > q0) { const int _qr = q0 + r32 - _kv0 - 4 * hi; _Pragma("unroll") for (int r = 0; r < 16; ++r) { if (CROWC(r) > _qr) C0[r] = -INFINITY; if (CROWC(r) + 32 > _qr) C1[r] = -INFINITY; } } \
            float _mx; DF_MAX(C0, C1, _mx); \
            if ((t) == 0) { m = _mx; _Pragma("unroll") for (int r = 0; r < 16; ++r) { C0[r] -= _mx; C1[r] -= _mx; negm[r] = -_mx; } }     \
            else if (__any(_mx > THR)) { if (pend) { DF_PV(PWO, (t) - 1); pend = false; } DF_RESCALE(C0, C1, fmaxf(_mx, 0.f)); } } \
        if (_actn) { DF_QK(N0, N1, (t) + 1); DF_MAX(N0, N1, mxc); } \
        if (pend) DF_PV(PWO, (t) - 1); \
        pend = false; \
        if (_act) { DF_SOFTMAX(C0, C1, PWN); pend = true; } \
        __syncthreads(); } while (0)

    f32x16 sa0, sa1, sb0, sb1; u32x4 pa[4], pb[4];
    bool pend = false; float mxc = 0.f;
    DF_DMAK(0); DF_DMAK(1);
    __syncthreads();
    DF_QK(sa0, sa1, 0);
    DF_STEP_GEN(sa0, sa1, sb0, sb1, pb, pa, 0);
    DF_STEP_GEN(sb0, sb1, sa0, sa1, pa, pb, 1);
    int t = 2;
    for (; t + 2 < t1; t += 2) {
        DF_STEP_FAST(sa0, sa1, sb0, sb1, pb, pa, t);
        DF_STEP_FAST(sb0, sb1, sa0, sa1, pa, pb, t + 1);
    }
    if (t < t1) {
        DF_STEP_GEN(sa0, sa1, sb0, sb1, pb, pa, t);
        DF_STEP_GEN(sb0, sb1, sa0, sa1, pa, pb, t + 1);
    }
    if (pend) DF_PV(pb, t1 - 1);
#undef DF_DMAK
#undef DF_KOFF
#undef DF_VOFF
#undef DF_KLD
#undef DF_VLD
#undef DF_QKM
#undef DF_PVM
#undef DF_MAX8
#undef DF_DMAV
#undef DF_SBAR
#undef DF_QK1
#undef DF_PV1
#undef DF_SM1
#undef DF_QK
#undef DF_PV
#undef DF_MAX
#undef DF_RESCALE
#undef DF_SOFTMAX
#undef DF_STEP_FAST
#undef DF_STEP_GEN
    l = xhalf_sum(l);
    scr[32 + r32] = l;
    float inv[16];
#pragma unroll
    for (int r = 0; r < 16; ++r) inv[r] = 1.0f / scr[32 + 4 * hi + CROWC(r)];
    const size_t orow0 = rowbase + q0;
    __syncthreads();
    ALAS float* ex = (ALAS float*)(lds + (w & 3) * 16384);
    if (w >= 4) {
#pragma unroll
        for (int d = 0; d < NDB; ++d)
#pragma unroll
            for (int r = 0; r < 16; ++r) ex[(d * 16 + r) * 64 + lane] = o[d][r] * inv[r];
    }
    __syncthreads();
    if (w < 4) {
        ALAS unsigned char* stg = lds + 69632 + w * 8192;
        float sw[NDB];
#pragma unroll
        for (int d = 0; d < NDB; ++d) sw[d] = subln_w[d * 32 + r32] * (1.0f - LAMBDA_INIT);
#pragma unroll
        for (int r = 0; r < 16; ++r) {
            float v[NDB]; float ss = 0.f;
#pragma unroll
            for (int d = 0; d < NDB; ++d) { v[d] = o[d][r] * inv[r] - lam * ex[(d * 16 + r) * 64 + lane]; ss += v[d] * v[d]; }
            ss += swz_xor<1>(ss); ss += swz_xor<2>(ss); ss += swz_xor<4>(ss); ss += swz_xor<8>(ss); ss += swz_xor<16>(ss);
            const float rn = rsqrtf(ss * (1.0f / 128.0f) + EPS);
#pragma unroll
            for (int d = 0; d < NDB; ++d) *(ALAS bf16_t*)(stg + (4 * hi + CROWC(r)) * 256 + (d * 32 + r32) * 2) = f2bf(v[d] * rn * sw[d]);
        }
        bf16_t* ob = ocat + orow0 * DM + hh * 128;
#pragma unroll
        for (int i = 0; i < 8; ++i) { const int idx = i * 64 + lane, row = idx >> 4, ch = idx & 15;
            *(u32x4*)(ob + (size_t)row * DM + ch * 8) = *(const ALAS u32x4*)(stg + row * 256 + ch * 16); }
    }
    __syncthreads();
}
}

namespace att {
constexpr int CR_SCR = 131072 + 14336;
template <class Sched>
__device__ __forceinline__ void cross_phase(ALAS unsigned char* lds, const bf16_t* __restrict__ qc, const bf16_t* __restrict__ kvc, unsigned char* __restrict__ oc, const Sched& S) {
    const int tid = fresh_tid(), w = __builtin_amdgcn_readfirstlane(tid >> 6);
    int lane = tid & 63;
    int r32 = lane & 31, hi = lane >> 5;
    unsigned koff = (unsigned)lane * (2112u * 2u), voff = (unsigned)(lane >> 2) * (2112u * 2u) + (unsigned)(lane & 3) * 16u;
    ALAS float* scr = (ALAS float*)(lds + CR_SCR + w * 256);
    pg8::Unit u, un;
    if (!S.next(0, u)) return;
#define CR_KSRC(uu) ((const char*)(kvc + (size_t)((uu).pm >> 4) * MEML * 2112 + (uu).pn * 256 + w * 8))
#define CR_VSRC(uu) ((const char*)(kvc + ((size_t)((uu).pm >> 4) * MEML + (w & 3) * 16) * 2112 + 1024 + (uu).pn * 256 + (w >> 2) * 32))
#define CR_QP(uu) (qc + ((size_t)(uu).pm * 256 + w * 32 + r32) * DM + (uu).pn * 256 + 8 * hi)
#define CR_DMAK(uu, dc, bo) do { const char* _s = CR_KSRC(uu) + (dc) * 128; _Pragma("unroll") for (int _i = 0; _i < 4; ++_i) \
        __builtin_amdgcn_global_load_lds((const unsigned*)(_s + (size_t)_i * (64 * 2112 * 2) + koff), (ALAS unsigned*)(lds + (bo) + (w * 256 + _i * 64) * 16), 16, 0, 0); } while (0)
#define CR_DMAV(uu, kc, bo) do { const char* _s = CR_VSRC(uu) + (size_t)(kc) * (64 * 2112 * 2); _Pragma("unroll") for (int _i = 0; _i < 4; ++_i) \
        __builtin_amdgcn_global_load_lds((const unsigned*)(_s + _i * 128 + voff), (ALAS unsigned*)(lds + (bo) + (w + 8 * _i) * 1024), 16, 0, 0); } while (0)
#define CR_SBAR() __builtin_amdgcn_sched_barrier(0)
#define CR_ENDSTAGE(iss) do { if (iss) asm volatile("s_waitcnt vmcnt(4) lgkmcnt(0)" ::: "memory"); else asm volatile("s_waitcnt vmcnt(0) lgkmcnt(0)" ::: "memory"); \
        __builtin_amdgcn_s_barrier(); asm volatile("" ::: "memory"); { const int _t = bA; bA = bB; bB = bC; bC = _t; } } while (0)
    int bA = 0, bB = 32768, bC = 65536;
    ALAS unsigned char* stg = lds + 98304 + w * 4096;
    bf16x8 qf[4], qn[4];
    { const bf16_t* qp = CR_QP(u);
#pragma unroll
      for (int d0 = 0; d0 < 4; ++d0) qf[d0] = *(const bf16x8*)(qp + 16 * d0); }
    CR_DMAK(u, 0, bA); CR_DMAK(u, 1, bB);
    asm volatile("s_waitcnt vmcnt(4)" ::: "memory"); __builtin_amdgcn_s_barrier(); asm volatile("" ::: "memory");
#pragma unroll 1
    for (int ui = 0;; ++ui) {
        const bool has_next = S.next(ui + 1, un);
        asm volatile("" : "+v"(lane));
        r32 = lane & 31; hi = lane >> 5; koff = (unsigned)lane * (2112u * 2u); voff = (unsigned)(lane >> 2) * (2112u * 2u) + (unsigned)(lane & 3) * 16u;
        const int vfrag = ((lane >> 4) & 1) * 32 + (lane & 3) * 8 + (4 * hi + ((lane & 15) >> 2)) * 64;
        const bf16_t* qp = CR_QP(u);
        f32x16 s[8];
#pragma unroll
        for (int kb = 0; kb < 8; ++kb) s[kb] = f32x16{};
#pragma unroll
        for (int dc = 0; dc < 4; ++dc) {
            if (dc < 3) {
#pragma unroll
                for (int d0 = 0; d0 < 4; ++d0) qn[d0] = *(const bf16x8*)(qp + (dc + 1) * 64 + 16 * d0);
            }
            if (dc < 2) CR_DMAK(u, dc + 2, bC); else CR_DMAV(u, dc - 2, bC);
            const ALAS unsigned char* kbase = lds + bA + (hi * 256 + r32) * 16;
            bf16x8 fa[2], fb[2];
#define CR_KLD(F, g) do { _Pragma("unroll") for (int k2 = 0; k2 < 2; ++k2) F[k2] = *(const ALAS bf16x8*)(kbase + (2 * (2 * ((g) & 1) + k2) * 256 + ((g) >> 1) * 32) * 16); } while (0)
#define CR_KMM(F, g) do { _Pragma("unroll") for (int k2 = 0; k2 < 2; ++k2) s[(g) >> 1] = __builtin_amdgcn_mfma_f32_32x32x16_bf16(F[k2], qf[2 * ((g) & 1) + k2], s[(g) >> 1], 0, 0, 0); } while (0)
            CR_KLD(fa, 0); CR_SBAR();
            CR_KLD(fb, 1); CR_KMM(fa, 0); CR_SBAR();
            CR_KLD(fa, 2); CR_KMM(fb, 1); CR_SBAR();
            CR_KLD(fb, 3); CR_KMM(fa, 2); CR_SBAR();
            CR_KLD(fa, 4); CR_KMM(fb, 3); CR_SBAR();
            CR_KLD(fb, 5); CR_KMM(fa, 4); CR_SBAR();
            CR_KLD(fa, 6); CR_KMM(fb, 5); CR_SBAR();
            CR_KLD(fb, 7); CR_KMM(fa, 6); CR_SBAR();
            CR_KLD(fa, 8); CR_KMM(fb, 7); CR_SBAR();
            CR_KLD(fb, 9); CR_KMM(fa, 8); CR_SBAR();
            CR_KLD(fa, 10); CR_KMM(fb, 9); CR_SBAR();
            CR_KLD(fb, 11); CR_KMM(fa, 10); CR_SBAR();
            CR_KLD(fa, 12); CR_KMM(fb, 11); CR_SBAR();
            CR_KLD(fb, 13); CR_KMM(fa, 12); CR_SBAR();
            CR_KLD(fa, 14); CR_KMM(fb, 13); CR_SBAR();
            CR_KLD(fb, 15); CR_KMM(fa, 14); CR_SBAR();
            CR_KMM(fb, 15); CR_SBAR();
#undef CR_KLD
#undef CR_KMM
            if (dc < 3) {
#pragma unroll
                for (int d0 = 0; d0 < 4; ++d0) qf[d0] = qn[d0];
            }
            CR_ENDSTAGE(true);
        }
        float mx = s[0][0];
#pragma unroll
        for (int kb = 0; kb < 8; ++kb)
#pragma unroll
            for (int r = 0; r < 16; ++r) mx = fmaxf(mx, s[kb][r]);
        mx = fmaxf(mx, __shfl_xor(mx, 32));
        float l = 0.f;
        u32x4 pw[16];
#pragma unroll
        for (int kb = 0; kb < 8; ++kb) {
#pragma unroll
            for (int r = 0; r < 16; ++r) { s[kb][r] = __builtin_amdgcn_exp2f(s[kb][r] - mx); l += s[kb][r]; }
#pragma unroll
            for (int s2 = 0; s2 < 2; ++s2)
                pw[kb * 2 + s2] = (u32x4){cvtpk(s[kb][8 * s2], s[kb][8 * s2 + 1]), cvtpk(s[kb][8 * s2 + 2], s[kb][8 * s2 + 3]), cvtpk(s[kb][8 * s2 + 4], s[kb][8 * s2 + 5]), cvtpk(s[kb][8 * s2 + 6], s[kb][8 * s2 + 7])};
        }
        l += __shfl_xor(l, 32);
        scr[r32] = l;
#pragma unroll
        for (int dh = 0; dh < 2; ++dh) {
            f32x16 o[4];
#pragma unroll
            for (int d = 0; d < 4; ++d) o[d] = f32x16{};
#pragma unroll
            for (int kc = 0; kc < 4; ++kc) {
                const int st = 4 + dh * 4 + kc;
                bool issued = true;
                if (st + 2 < 8) CR_DMAV(u, st + 2 - 4, bC); else if (st + 2 < 12) CR_DMAV(u, st + 2 - 8, bC); else if (has_next) CR_DMAK(un, st + 2 - 12, bC); else issued = false;
                const ALAS unsigned char* vb = lds + bA + vfrag + dh * 16384;
                bf16x8 fa[2], fb[2];
#define CR_VLD(F, g) do { _Pragma("unroll") for (int k2 = 0; k2 < 2; ++k2) { const s16x4 _lo = vtr(vb + ((g) >> 1) * 4096 + ((g) & 1) * 2048 + k2 * 1024), _hi = vtr(vb + ((g) >> 1) * 4096 + ((g) & 1) * 2048 + k2 * 1024 + 512); \
                F[k2] = (bf16x8){_lo[0], _lo[1], _lo[2], _lo[3], _hi[0], _hi[1], _hi[2], _hi[3]}; } } while (0)
#define CR_VMM(F, g) do { _Pragma("unroll") for (int k2 = 0; k2 < 2; ++k2) \
                o[(g) >> 1] = __builtin_amdgcn_mfma_f32_32x32x16_bf16(__builtin_bit_cast(bf16x8, pw[(2 * kc + ((g) & 1)) * 2 + k2]), F[k2], o[(g) >> 1], 0, 0, 0); } while (0)
                CR_VLD(fa, 0); CR_SBAR();
                CR_VLD(fb, 1); CR_VMM(fa, 0); CR_SBAR();
                CR_VLD(fa, 2); CR_VMM(fb, 1); CR_SBAR();
                CR_VLD(fb, 3); CR_VMM(fa, 2); CR_SBAR();
                CR_VLD(fa, 4); CR_VMM(fb, 3); CR_SBAR();
                CR_VLD(fb, 5); CR_VMM(fa, 4); CR_SBAR();
                CR_VLD(fa, 6); CR_VMM(fb, 5); CR_SBAR();
                CR_VLD(fb, 7); CR_VMM(fa, 6); CR_SBAR();
                CR_VMM(fb, 7); CR_SBAR();
#undef CR_VLD
#undef CR_VMM
                CR_ENDSTAGE(issued);
            }
            if (dh == 1 && has_next) { const bf16_t* qpn = CR_QP(un);
#pragma unroll
                for (int d0 = 0; d0 < 4; ++d0) qn[d0] = *(const bf16x8*)(qpn + 16 * d0); }
            float inv[16];
#pragma unroll
            for (int r = 0; r < 16; ++r) inv[r] = 16.0f / scr[4 * hi + CROWC(r)];
#pragma unroll
            for (int r = 0; r < 16; ++r)
#pragma unroll
                for (int d = 0; d < 4; ++d) *(ALAS unsigned char*)(stg + (4 * hi + CROWC(r)) * 128 + d * 32 + r32) = (unsigned char)__builtin_amdgcn_cvt_pk_fp8_f32(__builtin_amdgcn_fmed3f(o[d][r] * inv[r], -448.0f, 448.0f), 0.f, 0, false);
            unsigned char* ob = oc + ((size_t)u.pm * 256 + w * 32) * DM + u.pn * 256 + dh * 128;
#pragma unroll
            for (int i = 0; i < 4; ++i) { const int idx = i * 64 + lane, row = idx >> 3, ch = idx & 7;
                *(u32x4*)(ob + (size_t)row * DM + ch * 16) = *(const ALAS u32x4*)(stg + row * 128 + ch * 16); }
        }
        if (!has_next) break;
        u = un;
#pragma unroll
        for (int d0 = 0; d0 < 4; ++d0) qf[d0] = qn[d0];
    }
#undef CR_KSRC
#undef CR_VSRC
#undef CR_QP
#undef CR_DMAK
#undef CR_DMAV
#undef CR_SBAR
#undef CR_ENDSTAGE
}
}


namespace att {
template <class F>
__device__ __forceinline__ void swa_phase(ALAS unsigned char* lds, const bf16_t* __restrict__ projr, bf16_t* __restrict__ ocat, const float* __restrict__ sinks, int first, int stride, int count, F unit_of) {
    const int tid = fresh_tid(), w = __builtin_amdgcn_readfirstlane(tid >> 6);
    int lane = tid & 63;
    const int g = w >> 1, qsub = w & 1;
    ALAS float* scr = (ALAS float*)(lds + CR_SCR + w * 256);
    ALAS unsigned char* stg = lds + 98304 + w * 4096;
    if (first >= count) return;
    int ub, uh, uj; unit_of(first, ub, uh, uj);
#define SW_T0(j) ((j) >= 2 ? (j) - 2 : 0)
#define SW_DMA(b_, h_, j_, bo) do { const char* _ks = (const char*)(projr + (size_t)(b_) * SEQ * INW + SK0 + (h_) * 64 + w * 8); \
        const char* _vs = (const char*)(projr + ((size_t)(b_) * SEQ + (w & 3) * 16) * INW + SV0 + (h_) * 64 + (w >> 2) * 32); \
        const unsigned _ko = (unsigned)lane * (INW * 2), _vo = (unsigned)(lane >> 2) * (INW * 2) + (unsigned)(lane & 3) * 16; \
        for (int _t = SW_T0(j_); _t <= (j_); ++_t) { const int _sl = _t - SW_T0(j_); \
            __builtin_amdgcn_global_load_lds((const unsigned*)(_ks + (size_t)_t * (64 * INW * 2) + _ko), (ALAS unsigned*)(lds + (bo) + _sl * 8192 + w * 1024), 16, 0, 0); \
            __builtin_amdgcn_global_load_lds((const unsigned*)(_vs + (size_t)_t * (64 * INW * 2) + _vo), (ALAS unsigned*)(lds + (bo) + 24576 + _sl * 8192 + w * 1024), 16, 0, 0); } } while (0)
#define SW_QLD(Q, b_, h_, j_) do { const bf16_t* _qp = projr + ((size_t)(b_) * SEQ + (j_) * 64 + qsub * 32 + (lane & 31)) * INW + SQ0 + ((h_) * 4 + g) * 64 + 8 * (lane >> 5); \
        _Pragma("unroll") for (int d0 = 0; d0 < 4; ++d0) Q[d0] = *(const bf16x8*)(_qp + 16 * d0); } while (0)
    bf16x8 qf[4], qn[4];
    SW_QLD(qf, ub, uh, uj);
    SW_DMA(ub, uh, uj, 0);
    int bo = 0;
#pragma unroll 1
    for (int L = first; L < count; L += stride) {
        const bool has_next = L + stride < count;
        int nb = 0, nh = 0, nj = 0, nnt = 0;
        asm volatile("" : "+v"(lane));
        if (has_next) { unit_of(L + stride, nb, nh, nj); nnt = nj - SW_T0(nj) + 1; SW_QLD(qn, nb, nh, nj); SW_DMA(nb, nh, nj, 49152 - bo); }
        if (nnt == 3) asm volatile("s_waitcnt vmcnt(6)" ::: "memory"); else if (nnt == 2) asm volatile("s_waitcnt vmcnt(4)" ::: "memory"); else if (nnt == 1) asm volatile("s_waitcnt vmcnt(2)" ::: "memory"); else asm volatile("s_waitcnt vmcnt(0)" ::: "memory");
        __builtin_amdgcn_s_barrier(); asm volatile("" ::: "memory");
        const int r32 = lane & 31, hi = lane >> 5;
        const int q0 = uj * 64 + qsub * 32, t0 = SW_T0(uj);
        float m = sinks[uh * 4 + g] * 1.4426950408889634f, l = hi == 0 ? 1.0f : 0.f;
        f32x16 o[2]; o[0] = f32x16{}; o[1] = f32x16{};
        const int kfrag = hi * 1024 + r32 * 16;
        const int vfrag = 24576 + ((lane >> 4) & 1) * 32 + (lane & 3) * 8 + (4 * hi + ((lane & 15) >> 2)) * 64;
#pragma unroll 1
        for (int t = t0; t <= uj; ++t) {
            const int kv0 = t * 64, sl = t - t0;
            if ((kv0 > q0 + 31) || (q0 - (kv0 + 63) >= 128)) continue;
            const ALAS unsigned char* kb = lds + bo + sl * 8192 + kfrag;
            f32x16 p0 = f32x16{}, p1 = f32x16{};
#pragma unroll
            for (int d0 = 0; d0 < 4; ++d0) {
                const bf16x8 k0 = *(const ALAS bf16x8*)(kb + d0 * 2048), k1 = *(const ALAS bf16x8*)(kb + d0 * 2048 + 512);
                p0 = __builtin_amdgcn_mfma_f32_32x32x16_bf16(k0, qf[d0], p0, 0, 0, 0);
                p1 = __builtin_amdgcn_mfma_f32_32x32x16_bf16(k1, qf[d0], p1, 0, 0, 0);
            }
            if ((kv0 + 63 > q0) || (q0 + 31 - kv0 >= 128)) {
                const int qr = q0 + r32 - kv0 - 4 * hi;
#pragma unroll
                for (int r = 0; r < 16; ++r) {
                    if (CROWC(r) > qr || qr - CROWC(r) >= 128) p0[r] = -INFINITY;
                    if (CROWC(r) + 32 > qr || qr - CROWC(r) - 32 >= 128) p1[r] = -INFINITY;
                }
            }
            float mx = fmaxf(p0[0], p1[0]);
#pragma unroll
            for (int r = 1; r < 16; ++r) mx = fmaxf(mx, fmaxf(p0[r], p1[r]));
            mx = fmaxf(mx, __shfl_xor(mx, 32));
            if (__any(mx > m + THR)) {
                const float mn = fmaxf(m, mx), alpha = __builtin_amdgcn_exp2f(m - mn);
                m = mn; l *= alpha;
                scr[r32] = alpha;
#pragma unroll
                for (int r = 0; r < 16; ++r) { const float a = scr[4 * hi + CROWC(r)]; o[0][r] *= a; o[1][r] *= a; }
            }
            float ls = 0.f;
#pragma unroll
            for (int r = 0; r < 16; ++r) { p0[r] = __builtin_amdgcn_exp2f(p0[r] - m); p1[r] = __builtin_amdgcn_exp2f(p1[r] - m); ls += p0[r] + p1[r]; }
            l += ls;
            u32x4 pw[4];
#pragma unroll
            for (int s = 0; s < 2; ++s) {
                pw[s]     = (u32x4){cvtpk(p0[8 * s], p0[8 * s + 1]), cvtpk(p0[8 * s + 2], p0[8 * s + 3]), cvtpk(p0[8 * s + 4], p0[8 * s + 5]), cvtpk(p0[8 * s + 6], p0[8 * s + 7])};
                pw[2 + s] = (u32x4){cvtpk(p1[8 * s], p1[8 * s + 1]), cvtpk(p1[8 * s + 2], p1[8 * s + 3]), cvtpk(p1[8 * s + 4], p1[8 * s + 5]), cvtpk(p1[8 * s + 6], p1[8 * s + 7])};
            }
            const ALAS unsigned char* vb = lds + bo + sl * 8192 + vfrag;
#pragma unroll
            for (int d = 0; d < 2; ++d)
#pragma unroll
                for (int ks = 0; ks < 4; ++ks) {
                    const s16x4 lo = vtr(vb + d * 4096 + ks * 1024), hi4 = vtr(vb + d * 4096 + ks * 1024 + 512);
                    const bf16x8 vf = (bf16x8){lo[0], lo[1], lo[2], lo[3], hi4[0], hi4[1], hi4[2], hi4[3]};
                    o[d] = __builtin_amdgcn_mfma_f32_32x32x16_bf16(__builtin_bit_cast(bf16x8, pw[ks]), vf, o[d], 0, 0, 0);
                }
        }
        l += __shfl_xor(l, 32);
        scr[32 + r32] = l;
#pragma unroll
        for (int r = 0; r < 16; ++r) { const float inv = 1.0f / scr[32 + 4 * hi + CROWC(r)];
#pragma unroll
            for (int d = 0; d < 2; ++d) *(ALAS bf16_t*)(stg + (4 * hi + CROWC(r)) * 128 + (d * 32 + r32) * 2) = f2bf(o[d][r] * inv); }
        bf16_t* ob = ocat + ((size_t)ub * SEQ + q0) * DM + 512 + (uh * 4 + g) * 64;
#pragma unroll
        for (int i = 0; i < 4; ++i) { const int idx = i * 64 + lane, row = idx >> 3, ch = idx & 7;
            *(u32x4*)(ob + (size_t)row * DM + ch * 8) = *(const ALAS u32x4*)(stg + row * 128 + ch * 16); }
        asm volatile("s_waitcnt lgkmcnt(0)" ::: "memory"); __builtin_amdgcn_s_barrier(); asm volatile("" ::: "memory");
        ub = nb; uh = nh; uj = nj; bo = 49152 - bo;
#pragma unroll
        for (int d0 = 0; d0 < 4; ++d0) qf[d0] = qn[d0];
    }
#undef SW_T0
#undef SW_DMA
#undef SW_QLD
}
}

#define LAS __attribute__((address_space(3)))
#define GAS __attribute__((address_space(1)))
constexpr int NWAVES = 8;
constexpr int RING_BYTES = 131072;
constexpr int LX_BAR = RING_BYTES;
constexpr int LX_PST = RING_BYTES + 64;
constexpr int MOE_MAXU = 6;
constexpr int LX_TOK = RING_BYTES + 1024;
constexpr int LX_RST = LX_TOK + MOE_MAXU * 1024;
constexpr int LDS_BYTES = 147456;
static_assert(LX_RST + MOE_MAXU * 1024 <= LDS_BYTES, "LDS map");

constexpr size_t WS_WIN  = WS_END;
constexpr size_t WS_WOUT = WS_WIN + (size_t)(2304 + 2048) * 1024 * 2;
constexpr size_t WS_WQ   = WS_WOUT + (size_t)1024 * 1024 * 2;
constexpr size_t WS_WOC  = WS_WQ + (size_t)1024 * 1024 * 2;
constexpr size_t WS_WGU  = WS_WOC + (size_t)1024 * 1024 * 2;
constexpr size_t WS_WD   = WS_WGU + (size_t)32 * 1024 * 1024 * 2;
constexpr size_t WS_SSP1 = WS_WD + (size_t)32 * 1024 * 512 * 2;
constexpr size_t WS_SSP2 = WS_SSP1 + (size_t)NTOK * 16 * 4;
constexpr size_t WS_WR   = WS_SSP2 + (size_t)NTOK * 16 * 4;
constexpr int KVP = 2112;
constexpr size_t WS_KVC2 = WS_WR + (size_t)2 * 48 * 1024 * 2;
constexpr size_t WS_END2 = WS_KVC2 + (size_t)NMEM * KVP * 2;
static_assert(WS_END2 <= (size_t)512 * 1024 * 1024, "workspace too big");
constexpr int CW_BAR = 16;

#define XB_TMO      128
#define XB_XCNT(j)  (256  + 64 * (j))
#define XB_XSUB(j)  (1280 + 64 * (j))
#define XB_XGEN(j)  (2304 + 64 * (j))
#define XB_TOP      3328
#define XB_TOPGEN   3392
#define XCD_BAR_WORDS 3456
#define XB_SPIN_CAP (1u << 18)
__device__ __forceinline__ unsigned xb_ld(unsigned* p)              { return __hip_atomic_load(p, __ATOMIC_RELAXED, __HIP_MEMORY_SCOPE_AGENT); }
__device__ __forceinline__ unsigned xb_add(unsigned* p, unsigned v) { return __hip_atomic_fetch_add(p, v, __ATOMIC_RELAXED, __HIP_MEMORY_SCOPE_AGENT); }
__device__ __forceinline__ unsigned xb_xcc_id() { return (unsigned)__builtin_amdgcn_s_getreg((3 << 11) | 20) & 0xFu; }
#define XB_SPIN(cond, bar) do { unsigned _sp = 0; while (cond) { __builtin_amdgcn_s_sleep(1); \
    if ((++_sp & 255u) == 0u) { if (xb_ld(&(bar)[XB_TMO])) break; if (_sp > XB_SPIN_CAP) { atomicAdd(&(bar)[XB_TMO], 1u); break; } } } } while (0)
struct XcdBarrier { unsigned* bar; unsigned x; volatile LAS unsigned* st; };
__device__ __forceinline__ XcdBarrier xcd_barrier_post(unsigned* bar, volatile LAS unsigned* st) {
    XcdBarrier b; b.bar = bar; b.x = xb_xcc_id(); b.st = st;
    if (threadIdx.x == 0) (void)xb_add(&bar[XB_XCNT(b.x)], 1u);
    return b;
}
__device__ __forceinline__ void xcd_barrier_complete(unsigned* bar, unsigned x, unsigned& nloc, unsigned& nx) {
    const unsigned G = gridDim.x * gridDim.y * gridDim.z;
    unsigned sum, cnt, mine, sp = 0u;
    for (;;) {
        sum = 0u; cnt = 0u; mine = 0u;
#pragma unroll
        for (unsigned j = 0; j < 16; ++j) { const unsigned c = xb_ld(&bar[XB_XCNT(j)]); sum += c; cnt += (c > 0u) ? 1u : 0u; mine = (j == x) ? c : mine; }
        if (sum == G) break;
        __builtin_amdgcn_s_sleep(1);
        if ((++sp & 255u) == 0u) { if (xb_ld(&bar[XB_TMO])) break; if (sp > XB_SPIN_CAP) { atomicAdd(&bar[XB_TMO], 1u); break; } }
    }
    nloc = mine > 0u ? mine : 1u; nx = cnt > 0u ? cnt : 1u;
}
__device__ __forceinline__ void xcd_barrier(const XcdBarrier& b) {
    asm volatile("s_waitcnt vmcnt(0)" ::: "memory");
    __syncthreads();
    if (threadIdx.x == 0) {
        unsigned* bar = b.bar;
        __builtin_amdgcn_s_waitcnt(0);
        unsigned nloc = b.st[0], nx = b.st[1];
        if (nloc == 0u) { xcd_barrier_complete(bar, b.x, nloc, nx); b.st[0] = nloc; b.st[1] = nx; }
        const unsigned old = xb_add(&bar[XB_XSUB(b.x)], 1u);
        const unsigned gen = old / nloc;
        if (old + 1u == (gen + 1u) * nloc) {
            __builtin_amdgcn_fence(__ATOMIC_RELEASE, "agent");
            asm volatile("s_waitcnt vmcnt(0)" ::: "memory");
            const unsigned og = xb_add(&bar[XB_TOP], 1u);
            const unsigned tg = og / nx;
            if (og + 1u == (tg + 1u) * nx) xb_add(&bar[XB_TOPGEN], 1u);
            else XB_SPIN(xb_ld(&bar[XB_TOPGEN]) == tg, bar);
            __builtin_amdgcn_fence(__ATOMIC_ACQUIRE, "agent");
            xb_add(&bar[XB_XGEN(b.x)], 1u);
            asm volatile("s_waitcnt vmcnt(0)" ::: "memory");
        } else {
            XB_SPIN(xb_ld(&bar[XB_XGEN(b.x)]) == gen, bar);
            __builtin_amdgcn_fence(__ATOMIC_ACQUIRE, "agent");
            asm volatile("s_waitcnt vmcnt(0)" ::: "memory");
        }
    }
    __syncthreads();
}

struct MkArgs {
    const float* in[26];
    float* out; unsigned char* ws;
    int ph_lo, ph_hi, li, pad;
};

__device__ __forceinline__ unsigned pk2rn(float lo, float hi) { return (unsigned)f2bf(lo) | ((unsigned)f2bf(hi) << 16); }
__device__ __forceinline__ int in_rowmap(int n0);
struct P0Item { const float* W; bf16_t* WT; const float* gain; int K, N, dst_row0, k0, n0, rowmap; float q8; };
__device__ __forceinline__ void p0_item_load(const P0Item& it, pg8::f32x4 (&v)[16], int lane) {
    const float* src = it.W + (size_t)(it.k0 + 16 * (lane >> 4)) * it.N + it.n0 + (lane & 15) * 4;
#pragma unroll
    for (int i = 0; i < 16; ++i) v[i] = __builtin_nontemporal_load((const pg8::f32x4*)(src + (size_t)i * it.N));
}
__device__ __forceinline__ void p0_item_store(const P0Item& it, pg8::f32x4 (&v)[16], int lane) {
    const int n4 = (lane & 15) * 4, kq = lane >> 4;
    if (it.gain) {
#pragma unroll
        for (int i = 0; i < 16; ++i) v[i] = v[i] * it.gain[it.k0 + 16 * kq + i];
    }
    const int n = it.n0 + n4;
    int drow;
    if (it.rowmap == 0) drow = it.dst_row0 + n; else if (it.rowmap == 1) drow = in_rowmap(n & ~31) + (n & 31); else drow = it.dst_row0 + 256 * (n >> 7) + (n & 127);
    if (it.q8 != 0.f) {
#pragma unroll
        for (int j = 0; j < 4; ++j) {
            int w[4];
#pragma unroll
            for (int q = 0; q < 4; ++q) { int t = 0; t = __builtin_amdgcn_cvt_pk_fp8_f32(__builtin_amdgcn_fmed3f(v[4 * q][j] * it.q8, -448.0f, 448.0f), __builtin_amdgcn_fmed3f(v[4 * q + 1][j] * it.q8, -448.0f, 448.0f), t, false); t = __builtin_amdgcn_cvt_pk_fp8_f32(__builtin_amdgcn_fmed3f(v[4 * q + 2][j] * it.q8, -448.0f, 448.0f), __builtin_amdgcn_fmed3f(v[4 * q + 3][j] * it.q8, -448.0f, 448.0f), t, true); w[q] = t; }
            pg8::u32x4v o; o.x = (unsigned)w[0]; o.y = (unsigned)w[1]; o.z = (unsigned)w[2]; o.w = (unsigned)w[3];
            __builtin_nontemporal_store(o, (pg8::u32x4v*)((unsigned char*)it.WT + (size_t)(drow + j) * it.K + it.k0 + 16 * kq));
        }
        return;
    }
#pragma unroll
    for (int j = 0; j < 4; ++j) {
        pg8::u32x4v o0, o1;
        o0.x = pk2rn(v[0][j], v[1][j]); o0.y = pk2rn(v[2][j], v[3][j]); o0.z = pk2rn(v[4][j], v[5][j]); o0.w = pk2rn(v[6][j], v[7][j]);
        o1.x = pk2rn(v[8][j], v[9][j]); o1.y = pk2rn(v[10][j], v[11][j]); o1.z = pk2rn(v[12][j], v[13][j]); o1.w = pk2rn(v[14][j], v[15][j]);
        bf16_t* dst = it.WT + (size_t)(drow + j) * it.K + it.k0 + 16 * kq;
        *(pg8::u32x4v*)dst = o0; *(pg8::u32x4v*)(dst + 8) = o1;
    }
}
__device__ __forceinline__ int in_rowmap(int n0) {
    if (n0 < 1024 || (n0 >= 1536 && n0 < 2048)) { const int base = (n0 < 512) ? 0 : (n0 < 1024 ? 512 : 1536), cc = n0 - base; return base + 256 * (cc >> 8) + ((cc >> 5) & 1) * 128 + ((cc >> 6) & 3) * 32; }
    if (n0 < 1536) return n0;
    if (n0 < 2176) { const int cc = n0 - 2048; return 2048 + ((cc >> 5) & 1) * 128 + (cc >> 6) * 32; }
    const int e = n0 - 2176; return 2048 + (e >> 6) * 128 + 64 + (e & 63);
}

struct MoeIt { const float* src; unsigned char* dst; const float* gp; int N, K; float q8; bool gsel; };
__device__ __forceinline__ void moe_decode(MoeIt& m, int r, const float* w_gate, const float* w_up, const float* w_down, const float* ln_moe_w, unsigned char* Wgu8, unsigned char* Wd8, int lane) {
    constexpr int IE = 16 * 8 * 32;
    const int n4 = (lane & 15) * 4, kq = lane >> 4;
    const float* W; unsigned char* db; int k0, n, drow;
    if (r < 2 * IE) { const int up = r >= IE ? 1 : 0; if (up) r -= IE; const int e = r >> 7, q = r & 127, kb = q >> 3, nb = q & 7;
        W = (up ? w_up : w_gate) + (size_t)e * 1024 * 512; m.N = 512; m.K = 1024; k0 = kb * 64; n = nb * 64 + n4; drow = e * 1024 + up * 128 + 256 * (n >> 7) + (n & 127); db = Wgu8; m.q8 = 64.0f; m.gsel = true; }
    else { r -= 2 * IE; const int e = r >> 7, q = r & 127, kb = q >> 4, nb = q & 15;
        W = w_down + (size_t)e * 512 * 1024; m.N = 1024; m.K = 512; k0 = kb * 64; n = nb * 64 + n4; drow = e * 1024 + n; db = Wd8; m.q8 = 32.0f; m.gsel = false; }
    m.src = W + (size_t)(k0 + 16 * kq) * m.N + n;
    m.dst = db + (size_t)drow * m.K + k0 + 16 * kq;
    m.gp = ln_moe_w + k0 + 16 * kq;
}
__device__ __forceinline__ void moe_load(const MoeIt& m, pg8::f32x4 (&g)[4], pg8::f32x4 (&v)[16]) {
#pragma unroll
    for (int c = 0; c < 4; ++c) g[c] = *(const pg8::f32x4*)(m.gp + 4 * c);
#pragma unroll
    for (int i = 0; i < 16; ++i) v[i] = __builtin_nontemporal_load((const pg8::f32x4*)(m.src + (size_t)i * m.N));
}
__device__ __forceinline__ void moe_store(const MoeIt& m, const pg8::f32x4 (&g)[4], const pg8::f32x4 (&v)[16]) {
    float gq[16];
#pragma unroll
    for (int i = 0; i < 16; ++i) gq[i] = m.gsel ? g[i >> 2][i & 3] * m.q8 : m.q8;
#pragma unroll
    for (int j = 0; j < 4; ++j) {
        int w[4];
#pragma unroll
        for (int q = 0; q < 4; ++q) { int t = 0;
            t = __builtin_amdgcn_cvt_pk_fp8_f32(__builtin_amdgcn_fmed3f(v[4 * q][j] * gq[4 * q], -448.0f, 448.0f), __builtin_amdgcn_fmed3f(v[4 * q + 1][j] * gq[4 * q + 1], -448.0f, 448.0f), t, false);
            t = __builtin_amdgcn_cvt_pk_fp8_f32(__builtin_amdgcn_fmed3f(v[4 * q + 2][j] * gq[4 * q + 2], -448.0f, 448.0f), __builtin_amdgcn_fmed3f(v[4 * q + 3][j] * gq[4 * q + 3], -448.0f, 448.0f), t, true); w[q] = t; }
        pg8::u32x4v o; o.x = (unsigned)w[0]; o.y = (unsigned)w[1]; o.z = (unsigned)w[2]; o.w = (unsigned)w[3];
        __builtin_nontemporal_store(o, (pg8::u32x4v*)(m.dst + (size_t)j * m.K));
    }
}

__global__ void __launch_bounds__(NWAVES * 64, 2) mk_fwd(MkArgs args) {
    extern __shared__ __attribute__((aligned(16))) unsigned char lds_raw[];
    LAS unsigned char* lds = (LAS unsigned char*)lds_raw;
    const int tid = threadIdx.x, wave = __builtin_amdgcn_readfirstlane(tid >> 6);
    const int G = gridDim.x, bx = blockIdx.x;
    const int gw = bx * NWAVES + wave, NGW = G * NWAVES;
    unsigned char* ws = args.ws;
    unsigned* ctl = (unsigned*)(ws + WS_CTL);
#define KGP(T, v) ((T*)(__attribute__((address_space(1))) T*)(v))
#define KPTRS \
        const __attribute__((address_space(4))) unsigned long long* kp_ = (const __attribute__((address_space(4))) unsigned long long*)__builtin_amdgcn_kernarg_segment_ptr(); \
        asm volatile("" : "+s"(kp_)); \
        unsigned char* ws = KGP(unsigned char, kp_[27]); unsigned* ctl = (unsigned*)(ws + WS_CTL); float* const out_ = KGP(float, kp_[26]); \
        const float* x = KGP(const float, kp_[0]); const float* mem = KGP(const float, kp_[1]); const int* positions = (const int*)KGP(const float, kp_[2]); \
        const float* ln_mix_w = KGP(const float, kp_[3]); const float* w_in = KGP(const float, kp_[4]); \
        const float* w_out = KGP(const float, kp_[11]); const float* ln_cross_w = KGP(const float, kp_[12]); const float* ln_mem_w = KGP(const float, kp_[13]); const float* wq_cross = KGP(const float, kp_[14]); \
        const float* wkv_cross = KGP(const float, kp_[15]); const float* wo_cross = KGP(const float, kp_[16]); const float* ln_moe_w = KGP(const float, kp_[17]); \
        const float* w_group = KGP(const float, kp_[18]); const float* b_group = KGP(const float, kp_[19]); const float* w_expert = KGP(const float, kp_[20]); const float* b_expert = KGP(const float, kp_[21]); \
        const float* w_gate = KGP(const float, kp_[22]); const float* w_up = KGP(const float, kp_[23]); const float* w_down = KGP(const float, kp_[24]); const float* ln_final_w = KGP(const float, kp_[25]); \
        float* rstd0 = (float*)(ws + WS_RSTD0); float* rstdm = (float*)(ws + WS_RSTDM); float* rstd2 = (float*)(ws + WS_RSTD2); \
        float* ropet = (float*)(ws + WS_ROPE); \
        int* tok_e = (int*)(ws + WS_TOKE); int* tok_i = (int*)(ws + WS_TOKI); float* tok_g = (float*)(ws + WS_TOKG); int* explist = (int*)(ws + WS_EXPL); \
        bf16_t* kvc = (bf16_t*)(ws + WS_KVC2); \
        bf16_t* xb = (bf16_t*)(ws + WS_S0); bf16_t* mb = xb + (size_t)NTOK * DM; bf16_t* qc = (bf16_t*)(ws + WS_S0); bf16_t* hdn = (bf16_t*)(ws + WS_S0); \
        bf16_t* projr = (bf16_t*)(ws + WS_S1); bf16_t* oc = (bf16_t*)(ws + WS_S1); bf16_t* y = (bf16_t*)(ws + WS_S1); \
        bf16_t* ocat = (bf16_t*)(ws + WS_S2); bf16_t* h2b = (bf16_t*)(ws + WS_S2); \
        bf16_t* h1b = (bf16_t*)(ws + WS_S3); \
        bf16_t* WinT = (bf16_t*)(ws + WS_WIN); bf16_t* WoutT = (bf16_t*)(ws + WS_WOUT); bf16_t* WqT = (bf16_t*)(ws + WS_WQ); bf16_t* WocT = (bf16_t*)(ws + WS_WOC); \
        unsigned char* Wgu8 = ws + WS_WGU; unsigned char* Wd8 = ws + WS_WD; \
        unsigned char* h2q = ws + WS_WGU + (size_t)32 * 1024 * 1024; \
        unsigned char* hdn8 = ws + WS_S0; \
        unsigned char* y8 = ws + WS_S1; \
        unsigned char* Wq8 = ws + WS_WQ; unsigned char* Woc8 = ws + WS_WOC; \
        unsigned char* oc8 = ws + WS_S1; \
        unsigned char* h1q = ws + WS_S1 + (size_t)64 * 1024 * 1024; \
        float* ssp1 = (float*)(ws + WS_SSP1); float* ssp2 = (float*)(ws + WS_SSP2); \
        bf16_t* WrT = (bf16_t*)(ws + WS_WR); \
        int* counts = (int*)(ctl + CW_COUNTS);

    for (int u = tid; u < (LDS_BYTES - RING_BYTES) / 4; u += NWAVES * 64) ((LAS unsigned*)(lds + RING_BYTES))[u] = 0u;
    __syncthreads();
    XcdBarrier bar = xcd_barrier_post(ctl + CW_BAR + args.li * XCD_BAR_WORDS, (volatile LAS unsigned*)(lds + LX_BAR));
    const int lo = args.ph_lo, hi = args.ph_hi;
#define IN(k) (lo <= (k) && (k) < hi)
#define SEAM(k) do { if (IN(k) && IN((k) + 1)) xcd_barrier(bar); } while (0)

    constexpr int I0 = 16 * 36, I1 = 16 * 32, I2 = 16 * 16, IE = 16 * 8 * 32, ID = 8 * 16 * 32;
    constexpr int NMAIN = I0 + I1 + 3 * I2, NMOE = 2 * IE + ID;
#define P0_DECODE_MAIN(IT, idx) do { int r = (idx); \
            if (r < I0) { const int kb = r / 36, nb = r % 36; IT = P0Item{w_in, WinT, ln_mix_w, 1024, 2304, 0, kb * 64, nb * 64, 1, 0.f}; } \
            else if ((r -= I0) < I1) { const int kb = r / 32, nb = r % 32; IT = P0Item{wkv_cross, WinT, ln_mem_w, 1024, 2048, 2304, kb * 64, nb * 64, 0, 0.f}; } \
            else if ((r -= I1) < I2) { const int kb = r / 16, nb = r % 16; IT = P0Item{w_out, WoutT, nullptr, 1024, 1024, 0, kb * 64, nb * 64, 0, 0.f}; } \
            else if ((r -= I2) < I2) { const int kb = r / 16, nb = r % 16; IT = P0Item{wq_cross, (bf16_t*)Wq8, ln_cross_w, 1024, 1024, 0, kb * 64, nb * 64, 0, 64.0f}; } \
            else { r -= I2; const int kb = r / 16, nb = r % 16; IT = P0Item{wo_cross, (bf16_t*)Woc8, nullptr, 1024, 1024, 0, kb * 64, nb * 64, 0, 64.0f}; } } while (0)
#define P0_DECODE_MOE(IT, idx) do { int r = (idx); \
            if (r < 2 * IE) { const int up = r >= IE ? 1 : 0; if (up) r -= IE; const int e = r >> 7, q = r & 127, kb = q >> 3, nb = q & 7; \
                IT = P0Item{(up ? w_up : w_gate) + (size_t)e * 1024 * 512, (bf16_t*)Wgu8, ln_moe_w, 1024, 512, e * 1024 + up * 128, kb * 64, nb * 64, 2, 64.0f}; } \
            else { r -= 2 * IE; const int e = r >> 7, q = r & 127, kb = q >> 4, nb = q & 15; IT = P0Item{w_down + (size_t)e * 512 * 1024, (bf16_t*)Wd8, nullptr, 512, 1024, e * 1024, kb * 64, nb * 64, 0, 32.0f}; } } while (0)
#define P0_RUN(DEC, first, step, end) do { if ((first) < (end)) { \
            P0Item itc, itn; pg8::f32x4 vc[16], vn[16]; \
            DEC(itc, (first)); p0_item_load(itc, vc, lane); \
            for (int it = (first); it < (end); it += (step)) { \
                const bool has_next = it + (step) < (end); \
                if (has_next) { DEC(itn, it + (step)); p0_item_load(itn, vn, lane); } \
                p0_item_store(itc, vc, lane); \
                if (has_next) { itc = itn; _Pragma("unroll") for (int i = 0; i < 16; ++i) vc[i] = vn[i]; } \
            } } } while (0)
#define MOE_RUN(first, step, end) do { \
            const int cnt_ = (first) < (end) ? ((end) - (first) + (step) - 1) / (step) : 0, npair_ = cnt_ >> 1; \
            if (npair_ > 0) { \
                MoeIt ma, mb; pg8::f32x4 ga[4], gb[4], va[16], vb[16]; int r_ = (first); \
                moe_decode(ma, r_, w_gate, w_up, w_down, ln_moe_w, Wgu8, Wd8, lane); moe_load(ma, ga, va); __builtin_amdgcn_sched_barrier(0); \
                for (int p_ = 0; p_ < npair_ - 1; ++p_) { \
                    moe_decode(mb, r_ + (step), w_gate, w_up, w_down, ln_moe_w, Wgu8, Wd8, lane); moe_load(mb, gb, vb); __builtin_amdgcn_sched_barrier(0); \
                    moe_store(ma, ga, va); \
                    r_ += 2 * (step); \
                    moe_decode(ma, r_, w_gate, w_up, w_down, ln_moe_w, Wgu8, Wd8, lane); moe_load(ma, ga, va); __builtin_amdgcn_sched_barrier(0); \
                    moe_store(mb, gb, vb); \
                } \
                moe_decode(mb, r_ + (step), w_gate, w_up, w_down, ln_moe_w, Wgu8, Wd8, lane); moe_load(mb, gb, vb); __builtin_amdgcn_sched_barrier(0); \
                moe_store(ma, ga, va); moe_store(mb, gb, vb); \
            } \
            P0_RUN(P0_DECODE_MOE, (first) + 2 * npair_ * (step), (step), (end)); \
        } while (0)
    constexpr int P1_IPW = 0;
    const int p1rem = 1216 % G, p1idle_w = p1rem ? (G - p1rem) * NWAVES : 0;
    const int NA = p1idle_w * P1_IPW < NMOE ? p1idle_w * P1_IPW : NMOE;
    if (IN(0)) { KPTRS
        const int lane = fresh_tid() & 63;
        P0_RUN(P0_DECODE_MAIN, gw, NGW, I0 + I1);
        for (int idx = bx * 512 + tid; idx < 48 * 1024; idx += G * 512) {
            const int row = idx >> 10, k = idx & 1023, rr = row & 15, fq4 = rr >> 2, reg = rr & 3;
            const float wv = (row < 16 ? w_group[k * 4 + (row & 3)] : w_expert[k * 32 + 8 * fq4 + (row >= 32 ? 4 : 0) + reg]) * ln_moe_w[k];
            const bf16_t hb = f2bf(wv);
            WrT[idx] = hb; WrT[48 * 1024 + idx] = f2bf(wv - bf2f(hb));
        }
        {
            pg8::f32x4 vc[2][4], vn[2][4];
#define P0_XLOAD(V, row2) do { _Pragma("unroll") for (int h2 = 0; h2 < 2; ++h2) { const int row = (row2) * 2 + h2; const float* src = row < NTOK ? x + (size_t)row * DM : mem + (size_t)(row - NTOK) * DM; \
                _Pragma("unroll") for (int i = 0; i < 4; ++i) V[h2][i] = __builtin_nontemporal_load(&((const pg8::f32x4*)src)[lane + 64 * i]); } } while (0)
            if (gw < (NTOK + NMEM) / 2) P0_XLOAD(vc, gw);
            for (int row2 = gw; row2 < (NTOK + NMEM) / 2; row2 += NGW) {
                const bool has_next = row2 + NGW < (NTOK + NMEM) / 2;
                if (has_next) P0_XLOAD(vn, row2 + NGW);
#pragma unroll
                for (int h2 = 0; h2 < 2; ++h2) { const int row = row2 * 2 + h2; float ss = 0.f;
#pragma unroll
                    for (int i = 0; i < 4; ++i) { const pg8::f32x4 t = vc[h2][i]; ss += (t[0] * t[0] + t[1] * t[1]) + (t[2] * t[2] + t[3] * t[3]);
                        uint2 o; o.x = pk2rn(t[0], t[1]); o.y = pk2rn(t[2], t[3]); ((uint2*)(xb + (size_t)row * DM))[lane + 64 * i] = o; }
                    ss = wave_sum(ss);
                    if (lane == 0) { const float rs = rsqrtf(ss * (1.0f / DM) + EPS); if (row < NTOK) rstd0[row] = rs; else rstdm[row - NTOK] = rs; } }
                if (has_next) {
#pragma unroll
                    for (int h2 = 0; h2 < 2; ++h2)
#pragma unroll
                        for (int i = 0; i < 4; ++i) vc[h2][i] = vn[h2][i]; }
            }
#undef P0_XLOAD
        }
        for (int idx = bx * 512 + tid; idx < NTOK * 32; idx += G * 512) {
            const int row = idx >> 5, i = idx & 31;
            const double inv_freq = exp(-9.210340371976184 * (double)(2 * i) / 64.0);
            const double rev = (double)positions[row] * inv_freq * 0.15915494309189535;
            const float fr = (float)(rev - floor(rev));
            ((unsigned*)ropet)[idx] = (unsigned)f2bf(__builtin_amdgcn_cosf(fr)) | ((unsigned)f2bf(__builtin_amdgcn_sinf(fr)) << 16);
        }
    }
    SEAM(0);
    if (IN(1)) { KPTRS
        pg8::Gemm g{xb, WinT, NTOK + NMEM, 2304 + 2048, 1024}; pg8::InProjOrder S{G, bx};
        LAS float* rst = (LAS float*)(lds + LX_RST);
        { pg8::Unit u; float tv[MOE_MAXU]; bool ok[MOE_MAXU];
#pragma unroll
          for (int i = 0; i < MOE_MAXU; ++i) { ok[i] = S.next(i, u) && tid < 256; tv[i] = ok[i] ? rstd0[u.pm * 256 + tid] : 0.f; }
#pragma unroll
          for (int i = 0; i < MOE_MAXU; ++i) if (ok[i]) rst[i * 256 + tid] = tv[i];
          __syncthreads(); }
        pg8::EpiInProj E{projr, kvc, rst, (const unsigned*)ropet};
        pg8::gemm_phase<pg8::EpiInProj, pg8::InProjOrder, true, true, false>(lds, g, S, E);
        if (p1rem && bx >= p1rem) { KPTRS const int lane = fresh_tid() & 63; const int first = (bx - p1rem) * NWAVES + wave; P0_RUN(P0_DECODE_MOE, first, p1idle_w, NA); }
    }
    SEAM(1);
    if (IN(2)) { KPTRS
        const float* lq1 = KGP(const float, kp_[5]); const float* lk1 = KGP(const float, kp_[6]); const float* lq2 = KGP(const float, kp_[7]); const float* lk2 = KGP(const float, kp_[8]);
        const float* subln_w = KGP(const float, kp_[9]); const float* sinks = KGP(const float, kp_[10]);
        const int lane = fresh_tid() & 63;
        const float a1 = wave_sum(lq1[lane] * lk1[lane]), a2 = wave_sum(lq2[lane] * lk2[lane]);
        const float lam = __uint_as_float(__builtin_amdgcn_readfirstlane(__float_as_uint(expf(a1) - expf(a2) + LAMBDA_INIT)));
        const int vcu = (G % 8 == 0) ? (bx % 8) * (G / 8) + bx / 8 : bx;
        const int nb4 = 1;
        int L = vcu, nun = 0;
        for (; L < 1024 && nun < nb4; L += G, ++nun) {
            const int v = L & 255, bh = v >> 3, s = v & 7, i = ((L >> 8) + bh) & 3, qb = (i == 0) ? s : (i == 1) ? 15 - s : (i == 2) ? 16 + s : 31 - s;
            att::diff_unit(lds, projr, ocat, bh >> 2, bh & 3, qb, lam, subln_w);
        }
        { const int lane2 = fresh_tid() & 63; { KPTRS const int lane = lane2; MOE_RUN(NA + gw, NGW, NMOE); P0_RUN(P0_DECODE_MAIN, I0 + I1 + gw, NGW, NMAIN); } }
        for (; L < 1024; L += G) {
            const int v = L & 255, bh = v >> 3, s = v & 7, i = ((L >> 8) + bh) & 3, qb = (i == 0) ? s : (i == 1) ? 15 - s : (i == 2) ? 16 + s : 31 - s;
            att::diff_unit(lds, projr, ocat, bh >> 2, bh & 3, qb, lam, subln_w);
        }
        __syncthreads();
        att::swa_phase(lds, projr, ocat, sinks, vcu, G, 1024, [](int L, int& b_, int& h_, int& j_) { b_ = L >> 7; h_ = (L >> 6) & 1; j_ = L & 63; });
    }
    SEAM(2);
    if (IN(3)) { KPTRS
        pg8::Gemm g{ocat, WoutT, NTOK, 1024, 1024}; pg8::StaticOrder S; S.init(NTOK, 1024, G, bx);
        pg8::EpiRes E{xb, h1b, ssp1, h1q, 1.0f};
        pg8::gemm_phase<pg8::EpiRes, pg8::StaticOrder, true, true, false>(lds, g, S, E);
    }
    SEAM(3);
    if (IN(4)) { KPTRS
        pg8::Gemm g{(const bf16_t*)h1q, (const bf16_t*)Wq8, NTOK, 1024, 512}; pg8::StaticOrderUi S; S.init(NTOK, 1024, G, bx);
        LAS float* rst = (LAS float*)(lds + LX_RST);
        { pg8::Unit u;
#pragma unroll
          for (int i = 0; i < 2; ++i) if (S.next(i, u) && tid < 256) rst[i * 256 + tid] = pg8::rstd_from_ssp(ssp1, u.pm * 256 + tid) * (C2_CROSS / 64.0f);
          { pg8::Unit u2; if (S.next(2, u2)) for (int i = 2; i < MOE_MAXU && S.next(i, u2); ++i) if (tid < 256) rst[i * 256 + tid] = pg8::rstd_from_ssp(ssp1, u2.pm * 256 + tid) * (C2_CROSS / 64.0f); }
          __syncthreads(); }
        pg8::EpiScale E{qc, rst};
        pg8::gemm_phase<pg8::EpiScale, pg8::StaticOrderUi, true, true, false, true>(lds, g, S, E);
    }
    if (IN(4) && IN(5)) {
        asm volatile("s_waitcnt vmcnt(0)" ::: "memory"); __syncthreads();
        __builtin_amdgcn_fence(__ATOMIC_ACQUIRE, "agent"); asm volatile("s_waitcnt vmcnt(0)" ::: "memory"); __syncthreads();
    }
    if (IN(5)) { KPTRS
        pg8::StaticOrder S; S.init(NTOK, 1024, G, bx);
        att::cross_phase(lds, qc, kvc, oc8, S);
    }
    SEAM(5);
    if (IN(6)) { KPTRS
        pg8::Gemm g{(const bf16_t*)oc8, (const bf16_t*)Woc8, NTOK, 1024, 512}; pg8::StaticOrder S; S.init(NTOK, 1024, G, bx);
        pg8::EpiRes E{h1b, h2b, ssp2, h2q, 1.0f / 1024.0f};
        pg8::gemm_phase<pg8::EpiRes, pg8::StaticOrder, true, true, false, true>(lds, g, S, E);
    }
    SEAM(6);
    if (IN(7)) { KPTRS
        LAS float* part = (LAS float*)lds; LAS int* lcnt = (LAS int*)(lds + 98304); LAS int* gbase = lcnt + 32;
        const int lane = fresh_tid() & 63;
        const int fq = lane >> 4;
        for (int blk = bx; blk < NTOK / 128; blk += G) {
            if (tid < 32) lcnt[tid] = 0;
            pg8::bf16x8 wf[3][2][4];
            { const bf16_t* wh = WrT + (size_t)(lane & 15) * 1024 + 128 * wave + 8 * fq;
#pragma unroll
              for (int j = 0; j < 3; ++j)
#pragma unroll
                  for (int p = 0; p < 2; ++p)
#pragma unroll
                      for (int s = 0; s < 4; ++s) wf[j][p][s] = *(const pg8::bf16x8*)(wh + p * 49152 + j * 16384 + 32 * s); }
            int e0r[2], e1r[2], li0[2], li1[2]; float g0r[2], g1r[2], rsr[2]; bool actr[2];
#pragma unroll
            for (int r = 0; r < 2; ++r) {
#pragma unroll 1
                for (int gl = 0; gl < 4; ++gl) {
                    const int tok = blk * 128 + (4 * r + gl) * 16 + (lane & 15);
                    const bf16_t* ap = h2b + (size_t)tok * DM + 128 * wave + 8 * fq;
                    pg8::f32x4 acc[3];
#pragma unroll
                    for (int j = 0; j < 3; ++j) acc[j] = (pg8::f32x4){0.f, 0.f, 0.f, 0.f};
#pragma unroll
                    for (int s = 0; s < 4; ++s) { const pg8::bf16x8 a = *(const pg8::bf16x8*)(ap + 32 * s);
#pragma unroll
                        for (int j = 0; j < 3; ++j) { acc[j] = __builtin_amdgcn_mfma_f32_16x16x32_bf16(wf[j][0][s], a, acc[j], 0, 0, 0); acc[j] = __builtin_amdgcn_mfma_f32_16x16x32_bf16(wf[j][1][s], a, acc[j], 0, 0, 0); } }
#pragma unroll
                    for (int j = 0; j < 3; ++j)
#pragma unroll
                        for (int c = 0; c < 4; ++c) part[((wave * 4 + gl) * 12 + j * 4 + c) * 64 + lane] = acc[j][c];
                }
                __syncthreads();
                actr[r] = false; e0r[r] = 0; e1r[r] = 0; li0[r] = 0; li1[r] = 0; g0r[r] = 0.f; g1r[r] = 0.f; rsr[r] = 0.f;
                if (wave < 4) {
                    float v[12];
#pragma unroll
                    for (int q = 0; q < 12; ++q) v[q] = 0.f;
#pragma unroll 1
                    for (int ww = 0; ww < 8; ++ww) {
#pragma unroll
                        for (int q = 0; q < 12; ++q) v[q] += part[((ww * 4 + wave) * 12 + q) * 64 + lane]; }
                    const int tok = blk * 128 + (4 * r + wave) * 16 + (lane & 15);
                    const float rs = pg8::rstd_from_ssp(ssp2, tok);
                    float lg[4], el[8];
#pragma unroll
                    for (int j = 0; j < 4; ++j) { lg[j] = v[j] * rs + b_group[j]; el[j] = v[4 + j] * rs + b_expert[8 * fq + j]; el[4 + j] = v[8 + j] * rs + b_expert[8 * fq + 4 + j]; }
                    int gs = 0; float gm = lg[0];
#pragma unroll
                    for (int j = 1; j < 4; ++j) if (lg[j] > gm) { gm = lg[j]; gs = j; }
                    float gden = 0.f;
#pragma unroll
                    for (int j = 0; j < 4; ++j) gden += expf(lg[j] - gm);
                    const float gp = 1.0f / gden;
                    int i0 = 0; float v0 = el[0];
#pragma unroll
                    for (int j = 1; j < 8; ++j) if (el[j] > v0) { v0 = el[j]; i0 = j; }
                    int i1 = (i0 == 0) ? 1 : 0; float v1 = -INFINITY;
#pragma unroll
                    for (int j = 0; j < 8; ++j) if (j != i0 && el[j] > v1) { v1 = el[j]; i1 = j; }
                    const float w0 = 1.0f / (1.0f + expf(v1 - v0));
                    if (fq == gs) {
                        actr[r] = true; e0r[r] = gs * 8 + i0; e1r[r] = gs * 8 + i1; g0r[r] = gp * w0; g1r[r] = gp * (1.0f - w0); rsr[r] = rs;
                        li0[r] = __hip_atomic_fetch_add(lcnt + e0r[r], 1, __ATOMIC_RELAXED, __HIP_MEMORY_SCOPE_WORKGROUP);
                        li1[r] = __hip_atomic_fetch_add(lcnt + e1r[r], 1, __ATOMIC_RELAXED, __HIP_MEMORY_SCOPE_WORKGROUP);
                    }
                }
                __syncthreads();
            }
            if (tid < 32) gbase[tid] = atomicAdd(&counts[tid], lcnt[tid]);
            __syncthreads();
            if (wave < 4) {
#pragma unroll
                for (int r = 0; r < 2; ++r) if (actr[r]) {
                    const int tok = blk * 128 + (4 * r + wave) * 16 + (lane & 15);
                    const int e0 = e0r[r], e1 = e1r[r], x0 = gbase[e0] + li0[r], x1 = gbase[e1] + li1[r];
                    explist[(size_t)e0 * NTOK + x0] = tok; explist[(size_t)e1 * NTOK + x1] = tok;
                    tok_e[tok * 2] = e0; tok_e[tok * 2 + 1] = e1; tok_i[tok * 2] = x0; tok_i[tok * 2 + 1] = x1;
                    tok_g[tok * 2] = g0r[r]; tok_g[tok * 2 + 1] = g1r[r];
                    rstd2[tok] = rsr[r];
                }
            }
            __syncthreads();
        }
    }
    SEAM(7);
    if (IN(8) || IN(9)) { KPTRS
        LAS int* pst = (LAS int*)(lds + LX_PST);
        if (tid == 0) { int s = 0; for (int e = 0; e < 32; ++e) { pst[e] = s; s += (counts[e] + 255) >> 8; } pst[32] = s; }
        __syncthreads();
    }
    if (IN(8)) { KPTRS
        LAS int* pst = (LAS int*)(lds + LX_PST); LAS int* tokt = (LAS int*)(lds + LX_TOK); LAS float* rst = (LAS float*)(lds + LX_RST);
        pg8::MoeOrder S{G, bx, pst[32], pst, tokt};
        {
            pg8::Unit u; int tk[MOE_MAXU]; float tr[MOE_MAXU]; bool ok[MOE_MAXU];
#pragma unroll
            for (int i = 0; i < MOE_MAXU; ++i) { ok[i] = S.next(i, u) && tid < 256; tk[i] = 0;
                if (ok[i]) { const int e = u.pn >> 2, idx = (u.pm - pst[e]) * 256 + tid, cnt = counts[e]; tk[i] = explist[(size_t)e * NTOK + (idx < cnt ? idx : 0)]; } }
#pragma unroll
            for (int i = 0; i < MOE_MAXU; ++i) tr[i] = ok[i] ? rstd2[tk[i]] : 0.f;
#pragma unroll
            for (int i = 0; i < MOE_MAXU; ++i) if (ok[i]) { tokt[i * 256 + tid] = tk[i]; rst[i * 256 + tid] = tr[i]; }
            __syncthreads();
        }
        pg8::Gemm g{(const bf16_t*)h2q, (const bf16_t*)Wgu8, PMAX, 32 * 1024, 512};
        pg8::EpiGateUp E{hdn8, rst};
        pg8::gemm_phase<pg8::EpiGateUp, pg8::MoeOrder, true, true, true, true>(lds, g, S, E);
    }
    SEAM(8);
    if (IN(9)) { KPTRS
        LAS int* pst = (LAS int*)(lds + LX_PST);
        pg8::MoeOrder S{G, bx, pst[32], pst, (LAS int*)(lds + LX_TOK)};
        pg8::Gemm g{(const bf16_t*)hdn8, (const bf16_t*)Wd8, PMAX, 32 * 1024, 256};
        pg8::EpiDown E{y8};
        pg8::gemm_phase<pg8::EpiDown, pg8::MoeOrder, true, true, false, true>(lds, g, S, E);
    }
    SEAM(9);
    if (IN(10)) { KPTRS
        const int lane = fresh_tid() & 63;
        LAS int* sb = (LAS int*)(lds + LX_PST);
        __syncthreads();
        if (tid == 0) { int s = 0; for (int e = 0; e < 32; ++e) { sb[e] = s; s += (counts[e] + 255) & ~255; } }
        __syncthreads();
        struct Meta { int e0, e1, i0, i1; float g0, g1; };
#define P10_META(M, tok) do { const int2 _e = *(const int2*)(tok_e + (tok) * 2), _i = *(const int2*)(tok_i + (tok) * 2); const float2 _g = *(const float2*)(tok_g + (tok) * 2); \
            M.e0 = _e.x; M.e1 = _e.y; M.i0 = _i.x; M.i1 = _i.y; M.g0 = _g.x; M.g1 = _g.y; } while (0)
#define P10_ROWS(A, B, C, M, tok) do { const size_t _s0 = (size_t)(sb[M.e0] + M.i0), _s1 = (size_t)(sb[M.e1] + M.i1); \
            _Pragma("unroll") for (int i = 0; i < 4; ++i) { A[i] = ((const ushort4*)(h2b + (size_t)(tok) * DM))[lane + 64 * i]; B[i] = ((const unsigned*)(y8 + _s0 * DM))[lane + 64 * i]; C[i] = ((const unsigned*)(y8 + _s1 * DM))[lane + 64 * i]; } } while (0)
        Meta m0, m1, m2; ushort4 ac[4], an[4]; unsigned bc[4], cc[4], bn[4], cn[4];
        m0 = Meta{0, 0, 0, 0, 0.f, 0.f}; m1 = m0; m2 = m0;
        if (gw < NTOK) { P10_META(m0, gw); if (gw + NGW < NTOK) P10_META(m1, gw + NGW); P10_ROWS(ac, bc, cc, m0, gw); }
        for (int tok = gw; tok < NTOK; tok += NGW) {
            const bool has1 = tok + NGW < NTOK, has2 = tok + 2 * NGW < NTOK;
            if (has2) P10_META(m2, tok + 2 * NGW);
            if (has1) P10_ROWS(an, bn, cn, m1, tok + NGW);
            const float g0 = m0.g0 * (1.0f / 16.0f), g1 = m0.g1 * (1.0f / 16.0f);
            float v[16]; float ss = 0.f;
#pragma unroll
            for (int i = 0; i < 4; ++i) {
                const ushort4 a = ac[i]; const int b = (int)bc[i], c = (int)cc[i];
                v[4 * i + 0] = bf2f(a.x) + g0 * __builtin_amdgcn_cvt_f32_fp8(b, 0) + g1 * __builtin_amdgcn_cvt_f32_fp8(c, 0);
                v[4 * i + 1] = bf2f(a.y) + g0 * __builtin_amdgcn_cvt_f32_fp8(b, 1) + g1 * __builtin_amdgcn_cvt_f32_fp8(c, 1);
                v[4 * i + 2] = bf2f(a.z) + g0 * __builtin_amdgcn_cvt_f32_fp8(b, 2) + g1 * __builtin_amdgcn_cvt_f32_fp8(c, 2);
                v[4 * i + 3] = bf2f(a.w) + g0 * __builtin_amdgcn_cvt_f32_fp8(b, 3) + g1 * __builtin_amdgcn_cvt_f32_fp8(c, 3);
#pragma unroll
                for (int j = 0; j < 4; ++j) ss += v[4 * i + j] * v[4 * i + j];
            }
            ss = wave_sum(ss);
            const float rs = rsqrtf(ss * (1.0f / DM) + EPS);
#pragma unroll
            for (int i = 0; i < 4; ++i) {
                const float4 w = ((const float4*)ln_final_w)[lane + 64 * i];
                float4 o; o.x = v[4 * i] * rs * w.x; o.y = v[4 * i + 1] * rs * w.y; o.z = v[4 * i + 2] * rs * w.z; o.w = v[4 * i + 3] * rs * w.w;
                { pg8::f32x4 o4; o4[0] = o.x; o4[1] = o.y; o4[2] = o.z; o4[3] = o.w; __builtin_nontemporal_store(o4, &((pg8::f32x4*)(out_ + (size_t)tok * DM))[lane + 64 * i]); }
            }
            m0 = m1; m1 = m2;
#pragma unroll
            for (int i = 0; i < 4; ++i) { ac[i] = an[i]; bc[i] = bn[i]; cc[i] = cn[i]; }
        }
#undef P10_META
#undef P10_ROWS
    }
#undef IN
#undef SEAM
}

static void launch_mk(hipStream_t st, int grid, const MkArgs& base, int lo, int hi, int li) {
    MkArgs a = base; a.ph_lo = lo; a.ph_hi = hi; a.li = li; a.pad = 0;
    hipLaunchKernelGGL(mk_fwd, dim3(grid), dim3(NWAVES * 64), LDS_BYTES, st, a);
}

extern "C" void kernel_launch(void* const* d_in, const int* in_sizes, int n_in, void* d_out, int out_size, void* d_ws, size_t ws_size, hipStream_t stream) {
    (void)in_sizes; (void)n_in; (void)out_size; (void)ws_size;
    static int grid = 0;
    if (grid == 0) {
        int dev = 0, cus = 0, per_cu = 0;
        (void)hipGetDevice(&dev);
        (void)hipDeviceGetAttribute(&cus, hipDeviceAttributeMultiprocessorCount, dev);
        (void)hipFuncSetAttribute((const void*)mk_fwd, hipFuncAttributeMaxDynamicSharedMemorySize, LDS_BYTES);
        (void)hipOccupancyMaxActiveBlocksPerMultiprocessor(&per_cu, (const void*)mk_fwd, NWAVES * 64, LDS_BYTES);
        (void)hipGetLastError();
        grid = cus > 0 ? cus : 256;
    }
    char* ws = (char*)d_ws;

    (void)hipMemsetAsync(ws + WS_CTL, 0, CTL_BYTES, stream);
    MkArgs a; memset(&a, 0, sizeof(a));
    for (int i = 0; i < 26; ++i) a.in[i] = (const float*)d_in[i];
    a.out = (float*)d_out; a.ws = (unsigned char*)d_ws;
    launch_mk(stream, grid, a, 0, 11, 0);
}
```

```cpp
#include <hip/hip_runtime.h>
#include <stdint.h>
#include <string.h>

typedef unsigned short bf16_t;

constexpr int BATCH = 8, SEQ = 4096, DM = 1024, NTOK = BATCH * SEQ, MEML = 256, NMEM = BATCH * MEML;
constexpr int INW = 2304, DQ0 = 0, DK0 = 512, DV0 = 1024, SQ0 = 1536, SK0 = 2048, SV0 = 2176;
constexpr int NEXP = 32, DFF = 512, PMAX = 73728;
constexpr float EPS = 1e-6f;
constexpr float LOG2E = 1.4426950408889634f;
constexpr float C2_SELF = 0.125f * LOG2E;
constexpr float C2_CROSS = 0.0625f * LOG2E;
constexpr float LAMBDA_INIT = 0.2f;

constexpr size_t ALIGN_UP(size_t x) { return (x + 255) & ~(size_t)255; }
constexpr size_t WS_CTL   = 0;
constexpr size_t CTL_BYTES = 65536;
constexpr size_t WS_RSTD0 = WS_CTL + CTL_BYTES;
constexpr size_t WS_RSTDM = WS_RSTD0 + (size_t)NTOK * 4;
constexpr size_t WS_RSTD1 = WS_RSTDM + (size_t)NMEM * 4;
constexpr size_t WS_RSTD2 = WS_RSTD1 + (size_t)NTOK * 4;
constexpr size_t WS_ROPE  = WS_RSTD2 + (size_t)NTOK * 4;
constexpr size_t WS_TOKE  = WS_ROPE + (size_t)NTOK * 32 * 8;
constexpr size_t WS_TOKI  = WS_TOKE + (size_t)NTOK * 2 * 4;
constexpr size_t WS_TOKG  = WS_TOKI + (size_t)NTOK * 2 * 4;
constexpr size_t WS_EXPL  = WS_TOKG + (size_t)NTOK * 2 * 4;
constexpr size_t WS_KVC   = WS_EXPL + (size_t)NEXP * NTOK * 4;
constexpr size_t WS_S0    = WS_KVC + (size_t)NMEM * 2048 * 2;
constexpr size_t S0_BYTES = (size_t)PMAX * DFF * 2 > (size_t)(NTOK + NMEM) * DM * 2 ? (size_t)PMAX * DFF * 2 : (size_t)(NTOK + NMEM) * DM * 2;
constexpr size_t WS_S1    = WS_S0 + S0_BYTES;
constexpr size_t S1_BYTES = (size_t)NTOK * INW * 2;
constexpr size_t WS_S2    = WS_S1 + S1_BYTES;
constexpr size_t WS_S3    = WS_S2 + (size_t)NTOK * DM * 2;
constexpr size_t WS_END   = WS_S3 + (size_t)NTOK * DM * 2;
static_assert((size_t)PMAX * DM * 2 <= S1_BYTES, "y must fit S1");
static_assert(WS_END <= (size_t)512 * 1024 * 1024, "workspace too big");
constexpr int CW_COUNTS = 12288;

__device__ __forceinline__ float bf2f(bf16_t v) { return __uint_as_float(((unsigned)v) << 16); }
__device__ __forceinline__ bf16_t f2bf(float f) { unsigned u = __float_as_uint(f); u += 0x7FFFu + ((u >> 16) & 1u); return (bf16_t)(u >> 16); }
__device__ __forceinline__ float wave_sum(float v) {
#pragma unroll
    for (int o = 32; o >= 1; o >>= 1) v += __shfl_xor(v, o);
    return v;
}
__device__ __forceinline__ float wave_max(float v) {
#pragma unroll
    for (int o = 32; o >= 1; o >>= 1) v = fmaxf(v, __shfl_xor(v, o));
    return v;
}

__device__ __forceinline__ int fresh_tid() { int t = threadIdx.x; asm volatile("" : "+v"(t)); return t; }

namespace pg8 {
#define PG8_LAS __attribute__((address_space(3)))
typedef unsigned short bf16_t;
typedef short bf16x8 __attribute__((ext_vector_type(8)));
typedef float f32x4 __attribute__((ext_vector_type(4)));
typedef unsigned u32x4 __attribute__((ext_vector_type(4)));
constexpr int BM = 256, BK = 64, HALF = 128, HTB = HALF * BK * 2  , STAGE_BYTES = 8 * HTB, NXCD = 8, WGM = 8;

__host__ __device__ __forceinline__ int lds_byte(int r, int c) { const int st = (r >> 4) * 2 + (c >> 5), rr = r & 15, cc = c & 31, ob = rr * 64 + cc * 2; return st * 1024 + (ob ^ (((ob >> 9) & 1) << 5)); }
__host__ __device__ __forceinline__ void stage_rc(int b, int& R, int& C) { const int st = b / 1024, sb = b % 1024, swz = sb ^ (((sb >> 9) & 1) << 5); R = (st >> 1) * 16 + swz / 64; C = (st & 1) * 32 + (swz % 64) / 2; }
__host__ __device__ __forceinline__ int perm32(int rho) { const int n = rho >> 4, i = rho & 15; return 8 * (i >> 2) + 4 * n + (i & 3); }

struct Unit { int pm, pn, ui; };
struct Gemm { const bf16_t* A; const bf16_t* Bt; int M, N, K; int KA = 0; };

struct StaticOrder {
    static constexpr bool WT = false;
    int nM, nN, nwg, G, c;
    __host__ __device__ void init(int M, int N, int G_, int c_) { nM = M / BM; nN = N / BM; nwg = nM * nN; G = G_; c = c_; }
    __host__ __device__ __forceinline__ bool next(int i, Unit& u) const {
        const long L = (long)i * G + c; if (L >= nwg) return false;
        int wgid = (int)L; { const int q = nwg / NXCD, r = nwg % NXCD, xcd = wgid % NXCD, off = wgid / NXCD; wgid = (xcd < r ? xcd * (q + 1) : r * (q + 1) + (xcd - r) * q) + off; }
        const int nig = WGM * nN, gid = wgid / nig, fm = gid * WGM, gsz = (nM - fm) < WGM ? (nM - fm) : WGM;
        u.pm = fm + ((wgid % nig) % gsz); u.pn = (wgid % nig) / gsz; return true;
    }
    __device__ __forceinline__ void a_ready(const Unit&) const {}
    __device__ __forceinline__ void done(const Unit&) const {}
};

__device__ __forceinline__ unsigned cvt_pk_bf16(float lo, float hi) { unsigned r; asm volatile("v_cvt_pk_bf16_f32 %0, %1, %2" : "=v"(r) : "v"(lo), "v"(hi)); return r; }
typedef float f32x2 __attribute__((ext_vector_type(2)));

template <class Epi, class Sched, bool ALIGN_EPI = false, bool SP2 = false, bool GATHER = false, bool FP8 = false>
__device__ __forceinline__ void gemm_phase(PG8_LAS unsigned char* lds, const Gemm g, const Sched& S, const Epi& E) {
    const int tid = fresh_tid(), wid = __builtin_amdgcn_readfirstlane(tid >> 6), lane = tid & 63, wr = wid >> 2, wc = wid & 3, fr = lane & 15, fq = lane >> 4;
    const int K = g.K, nt = K / BK, KA = g.KA ? g.KA : K;
    unsigned voffA[2], voffB[2];
#pragma unroll
    for (int i = 0; i < 2; ++i) { int R, C; stage_rc(tid * 16 + i * 8192, R, C); const int Rb = Epi::PERM ? ((R & ~31) + perm32(R & 31)) : R;
        voffA[i] = (unsigned)(R * KA + C) * 2u; voffB[i] = (unsigned)(Rb * K + C) * 2u; }
    const int pg8_sc7f = 0x7f7f7f7f;
    unsigned gC[2][2] = {{0u, 0u}, {0u, 0u}}, gN[2][2] = {{0u, 0u}, {0u, 0u}};
#define PG8_GOFF(dst, uu) do { _Pragma("unroll") for (int _i = 0; _i < 2; ++_i) { int _R, _C; stage_rc(tid * 16 + _i * 8192, _R, _C); \
        dst[0][_i] = (unsigned)S.arow(uu, _R) * (unsigned)(K * 2) + (unsigned)_C * 2u; dst[1][_i] = (unsigned)S.arow(uu, HALF + _R) * (unsigned)(K * 2) + (unsigned)_C * 2u; } } while (0)
    const size_t kstep = (size_t)(BK * 2);
    const size_t hstep = (size_t)HALF * K * 2;
    const size_t tstep = 2 * hstep;
    const size_t hstepA = (size_t)HALF * KA * 2, tstepA = 2 * hstepA;
    const unsigned ldsw = (unsigned)wid * 1024u;
    const int aoff = lds_byte(wr * 64 + fr, fq * 8), boff = lds_byte(wc * 32 + fr, fq * 8);
#define PG8_SA(b, h) (((b) * 2 + (h)) * HTB)
#define PG8_SB(b, h) ((4 + (b) * 2 + (h)) * HTB)
#define PG8_STAGE(bufoff, gbase, voff) do { _Pragma("unroll") for (int _i = 0; _i < 2; ++_i) \
        __builtin_amdgcn_global_load_lds((const unsigned*)((const char*)(gbase) + (voff)[_i]), (PG8_LAS unsigned*)(lds + (bufoff) + ldsw + _i * 8192), 16, 0, 0); } while (0)
#define PG8_STAGE_A(bufoff, gbase, h, nx) do { _Pragma("unroll") for (int _i = 0; _i < 2; ++_i) { \
        const unsigned _o = GATHER ? ((nx) ? gN[h][_i] : gC[h][_i]) : voffA[_i]; \
        __builtin_amdgcn_global_load_lds((const unsigned*)((const char*)(gbase) + (GATHER ? (size_t)0 : (size_t)(h) * hstepA) + _o), (PG8_LAS unsigned*)(lds + (bufoff) + ldsw + _i * 8192), 16, 0, 0); } } while (0)
#define PG8_LDA(dst, b, h) do { _Pragma("unroll") for (int m = 0; m < 4; ++m) _Pragma("unroll") for (int k = 0; k < 2; ++k) dst[m][k] = *(const PG8_LAS bf16x8*)(lds + PG8_SA(b, h) + aoff + m * 2048 + k * 1024); } while (0)
#define PG8_LDB(dst, b, h) do { _Pragma("unroll") for (int n = 0; n < 2; ++n) _Pragma("unroll") for (int k = 0; k < 2; ++k) dst[n][k] = *(const PG8_LAS bf16x8*)(lds + PG8_SB(b, h) + boff + n * 2048 + k * 1024); } while (0)
#define PG8_MMA(ai, bj, At, Bt) do { __builtin_amdgcn_s_setprio(1); _Pragma("unroll") for (int m = 0; m < 4; ++m) _Pragma("unroll") for (int n = 0; n < 2; ++n) { \
        if constexpr (FP8) { typedef int v4i_ __attribute__((ext_vector_type(4))); typedef int v8i_ __attribute__((ext_vector_type(8))); \
            const v4i_ _b0 = __builtin_bit_cast(v4i_, Bt[n][0]), _b1 = __builtin_bit_cast(v4i_, Bt[n][1]), _a0 = __builtin_bit_cast(v4i_, At[m][0]), _a1 = __builtin_bit_cast(v4i_, At[m][1]); \
            const v8i_ _bb = __builtin_shufflevector(_b0, _b1, 0, 1, 2, 3, 4, 5, 6, 7), _aa = __builtin_shufflevector(_a0, _a1, 0, 1, 2, 3, 4, 5, 6, 7); \
            asm("v_mfma_scale_f32_16x16x128_f8f6f4 %0, %1, %2, %0, %3, %3 op_sel_hi:[0,0,0]" : "+v"(acc[ai][bj][m][n]) : "v"(_bb), "v"(_aa), "v"(pg8_sc7f)); } \
        else { _Pragma("unroll") for (int k = 0; k < 2; ++k) acc[ai][bj][m][n] = __builtin_amdgcn_mfma_f32_16x16x32_bf16(Bt[n][k], At[m][k], acc[ai][bj][m][n], 0, 0, 0); } } \
        __builtin_amdgcn_s_setprio(0); } while (0)
#define PG8_WAIT_V(n) asm volatile("s_waitcnt vmcnt(" #n ")" ::: "memory")
#define PG8_WAIT_L(n) asm volatile("s_waitcnt lgkmcnt(" #n ")" ::: "memory")
#define PG8_BAR __builtin_amdgcn_s_barrier()
#define PG8_SCHED __builtin_amdgcn_sched_barrier(0)
    Unit cur, nxt; int ui = 0;
    if (!S.next(0, cur)) return;
    f32x4 acc[2][2][4][2];
#pragma unroll
    for (int a = 0; a < 2; ++a)
#pragma unroll
        for (int b = 0; b < 2; ++b)
#pragma unroll
            for (int m = 0; m < 4; ++m)
#pragma unroll
                for (int n = 0; n < 2; ++n) acc[a][b][m][n] = (f32x4){0.f, 0.f, 0.f, 0.f};
    bf16x8 At[4][2], B0[2][2], B1[2][2];
    const char* cA = GATHER ? (const char*)g.A : (const char*)g.A + (size_t)cur.pm * tstepA; const char* cB = (const char*)g.Bt + (size_t)cur.pn * tstep;
    if constexpr (GATHER) { PG8_GOFF(gC, cur); }
    S.a_ready(cur);
    if constexpr (SP2) {
        PG8_STAGE(PG8_SB(0, 0), cB, voffB); PG8_STAGE(PG8_SB(0, 1), cB + hstep, voffB); PG8_STAGE_A(PG8_SA(0, 0), cA, 0, false); PG8_STAGE_A(PG8_SA(0, 1), cA, 1, false);
        if (wr == 1) PG8_BAR;
        PG8_WAIT_V(2); PG8_BAR;
        PG8_STAGE(PG8_SB(1, 0), cB + kstep, voffB); PG8_STAGE_A(PG8_SA(1, 0), cA + kstep, 0, false); PG8_STAGE(PG8_SB(1, 1), cB + hstep + kstep, voffB);
        PG8_WAIT_V(6); PG8_BAR;
    } else {
        PG8_STAGE(PG8_SB(0, 0), cB, voffB); PG8_STAGE_A(PG8_SA(0, 0), cA, 0, false); PG8_STAGE(PG8_SB(0, 1), cB + hstep, voffB); PG8_STAGE_A(PG8_SA(0, 1), cA, 1, false);
        if (wr == 1) PG8_BAR;
        PG8_WAIT_V(4); PG8_BAR;
        PG8_STAGE(PG8_SB(1, 0), cB + kstep, voffB); PG8_STAGE_A(PG8_SA(1, 0), cA + kstep, 0, false); PG8_STAGE(PG8_SB(1, 1), cB + hstep + kstep, voffB);
        PG8_WAIT_V(6); PG8_BAR;
    }
    for (;;) {
        const bool has_next = S.next(ui + 1, nxt);
        const char* nA = GATHER ? cA : (has_next ? (const char*)g.A + (size_t)nxt.pm * tstepA : cA); const char* nB = has_next ? (const char*)g.Bt + (size_t)nxt.pn * tstep : cB;
        for (int t = 0; t < nt; t += 2) {
            const bool last = (t == nt - 2);
            const char* a1 = cA + (size_t)(t + 1) * kstep;
            const char* a2 = last ? nA : cA + (size_t)(t + 2) * kstep; const char* b2 = last ? nB : cB + (size_t)(t + 2) * kstep;
            const char* a3 = a2 + kstep; const char* b3 = b2 + kstep;
            if (last && has_next) S.a_ready(nxt);
            if constexpr (GATHER) { if (last) { if (has_next) { PG8_GOFF(gN, nxt); } else { gN[0][0] = gC[0][0]; gN[0][1] = gC[0][1]; gN[1][0] = gC[1][0]; gN[1][1] = gC[1][1]; } } }
            if constexpr (SP2) {
            PG8_LDB(B0, 0, 0); PG8_LDB(B1, 0, 1); PG8_SCHED; PG8_LDA(At, 0, 0); PG8_STAGE_A(PG8_SA(1, 1), a1, 1, false);
            PG8_WAIT_V(8); PG8_WAIT_L(0); PG8_BAR; PG8_MMA(0, 0, At, B0); PG8_MMA(0, 1, At, B1); PG8_BAR; PG8_SCHED;
            PG8_LDA(At, 0, 1); PG8_STAGE(PG8_SB(0, 0), b2, voffB); PG8_STAGE(PG8_SB(0, 1), b2 + hstep, voffB); PG8_STAGE_A(PG8_SA(0, 0), a2, 0, last);
            PG8_WAIT_V(8); PG8_WAIT_L(0); PG8_BAR; PG8_MMA(1, 0, At, B0); PG8_MMA(1, 1, At, B1); PG8_BAR; PG8_SCHED;
            PG8_LDB(B0, 1, 0); PG8_LDB(B1, 1, 1); PG8_SCHED; PG8_LDA(At, 1, 0); PG8_STAGE_A(PG8_SA(0, 1), a2, 1, last);
            PG8_WAIT_V(8); PG8_WAIT_L(0); PG8_BAR; PG8_MMA(0, 0, At, B0); PG8_MMA(0, 1, At, B1); PG8_BAR; PG8_SCHED;
            PG8_LDA(At, 1, 1); PG8_STAGE(PG8_SB(1, 0), b3, voffB); PG8_STAGE(PG8_SB(1, 1), b3 + hstep, voffB); PG8_STAGE_A(PG8_SA(1, 0), a3, 0, last);
            PG8_WAIT_V(8); PG8_WAIT_L(0); PG8_BAR; PG8_MMA(1, 0, At, B0); PG8_MMA(1, 1, At, B1); PG8_BAR; PG8_SCHED;
            } else {
            PG8_LDB(B0, 0, 0); PG8_SCHED; PG8_LDA(At, 0, 0); PG8_STAGE_A(PG8_SA(1, 1), a1, 1, false);
            PG8_WAIT_L(8); PG8_BAR; PG8_WAIT_L(0); PG8_MMA(0, 0, At, B0); PG8_BAR; PG8_SCHED;
            PG8_LDB(B1, 0, 1); PG8_STAGE(PG8_SB(0, 0), b2, voffB);
            PG8_BAR; PG8_WAIT_L(0); PG8_MMA(0, 1, At, B1); PG8_BAR;
            PG8_LDA(At, 0, 1); PG8_STAGE_A(PG8_SA(0, 0), a2, 0, last);
            PG8_BAR; PG8_WAIT_L(0); PG8_MMA(1, 0, At, B0); PG8_BAR; PG8_SCHED;
            PG8_STAGE(PG8_SB(0, 1), b2 + hstep, voffB);
            PG8_WAIT_V(6); PG8_BAR; PG8_MMA(1, 1, At, B1); PG8_BAR;
            PG8_LDB(B0, 1, 0); PG8_SCHED; PG8_LDA(At, 1, 0); PG8_STAGE_A(PG8_SA(0, 1), a2, 1, last);
            PG8_WAIT_L(8); PG8_BAR; PG8_WAIT_L(0); PG8_MMA(0, 0, At, B0); PG8_BAR; PG8_SCHED;
            PG8_LDB(B1, 1, 1); PG8_STAGE(PG8_SB(1, 0), b3, voffB);
            PG8_BAR; PG8_WAIT_L(0); PG8_MMA(0, 1, At, B1); PG8_BAR;
            PG8_LDA(At, 1, 1); PG8_STAGE_A(PG8_SA(1, 0), a3, 0, last);
            PG8_BAR; PG8_WAIT_L(0); PG8_MMA(1, 0, At, B0); PG8_BAR; PG8_SCHED;
            PG8_STAGE(PG8_SB(1, 1), b3 + hstep, voffB);
            PG8_WAIT_V(6); PG8_BAR; PG8_MMA(1, 1, At, B1); PG8_BAR;
            }
        }
        if constexpr (ALIGN_EPI) { if (wr == 0) PG8_BAR; }
        if constexpr (FP8) asm volatile("s_nop 15\n\ts_nop 15" ::: "memory");
        if constexpr (!Epi::AFTER_DRAIN) { E(acc, cur, wr, wc, fr, fq); S.done(cur); }
        if (!has_next) break;
#pragma unroll
        for (int a = 0; a < 2; ++a)
#pragma unroll
            for (int b = 0; b < 2; ++b)
#pragma unroll
                for (int m = 0; m < 4; ++m)
#pragma unroll
                    for (int n = 0; n < 2; ++n) acc[a][b][m][n] = (f32x4){0.f, 0.f, 0.f, 0.f};
        cur = nxt; cA = nA; cB = nB; ++ui;
        if constexpr (GATHER) { gC[0][0] = gN[0][0]; gC[0][1] = gN[0][1]; gC[1][0] = gN[1][0]; gC[1][1] = gN[1][1]; }
        if constexpr (ALIGN_EPI) { if (wr == 1) PG8_BAR; }
    }
    PG8_WAIT_V(0);
    if constexpr (!ALIGN_EPI) { if (wr == 0) PG8_BAR; }
    PG8_BAR;
    if constexpr (Epi::AFTER_DRAIN) { E.fused(acc, cur, wr, wc, fr, fq, lds, wid, lane); S.done(cur); }
#undef PG8_SA
#undef PG8_SB
#undef PG8_STAGE
#undef PG8_STAGE_A
#undef PG8_GOFF
#undef PG8_LDA
#undef PG8_LDB
#undef PG8_MMA
#undef PG8_WAIT_V
#undef PG8_WAIT_L
#undef PG8_BAR
#undef PG8_SCHED
}


__device__ __forceinline__ void order_map(int L, int nM, int nN, int& pm, int& pn) {
    const int nwg = nM * nN; int wgid = L; { const int q = nwg / NXCD, r = nwg % NXCD, xcd = wgid % NXCD, off = wgid / NXCD; wgid = (xcd < r ? xcd * (q + 1) : r * (q + 1) + (xcd - r) * q) + off; }
    const int nig = WGM * nN, gid = wgid / nig, fm = gid * WGM, gsz = (nM - fm) < WGM ? (nM - fm) : WGM;
    pm = fm + ((wgid % nig) % gsz); pn = (wgid % nig) / gsz;
}
struct StaticOrderUi : StaticOrder {
    __device__ __forceinline__ bool next(int i, Unit& u) const { u.ui = i; return StaticOrder::next(i, u); }
};
struct InProjOrder {
    int G, c;
    __device__ __forceinline__ bool next(int i, Unit& u) const {
        const int L = i * G + c; u.ui = i;
        if (L < 1152) { order_map(L, 128, 9, u.pm, u.pn); return true; }
        if (L < 1152 + 64) { int a, b2; order_map(L - 1152, 8, 8, a, b2); u.pm = 128 + b2; u.pn = 9 + a; return true; }
        return false;
    }
    __device__ __forceinline__ void a_ready(const Unit&) const {}
    __device__ __forceinline__ void done(const Unit&) const {}
};
struct MoeOrder {
    int G, c, nP;
    const PG8_LAS int* pst;
    const PG8_LAS int* tokt;
    __device__ __forceinline__ bool next(int i, Unit& u) const {
        const int L = i * G + c; if (L >= nP * 4) return false;
        int sp, pnl; order_map(L, nP, 4, sp, pnl);
        int e = 0;
#pragma unroll 1
        for (int j = 1; j < 32; ++j) e += (pst[j] <= sp) ? 1 : 0;
        u.pm = sp; u.pn = e * 4 + pnl; u.ui = i; return true;
    }
    __device__ __forceinline__ int arow(const Unit& u, int R) const { return tokt[u.ui * 256 + R]; }
    __device__ __forceinline__ void a_ready(const Unit&) const {}
    __device__ __forceinline__ void done(const Unit&) const {}
};

typedef unsigned u32x4v __attribute__((ext_vector_type(4)));
__device__ __forceinline__ u32x4v pack8(const f32x4& a, const f32x4& b) { u32x4v w; w.x = cvt_pk_bf16(a[0], a[1]); w.y = cvt_pk_bf16(a[2], a[3]); w.z = cvt_pk_bf16(b[0], b[1]); w.w = cvt_pk_bf16(b[2], b[3]); return w; }
__device__ __forceinline__ void unpack8(const u32x4v w, f32x4& a, f32x4& b) {
    a[0] = __uint_as_float(w.x << 16); a[1] = __uint_as_float(w.x & 0xffff0000u); a[2] = __uint_as_float(w.y << 16); a[3] = __uint_as_float(w.y & 0xffff0000u);
    b[0] = __uint_as_float(w.z << 16); b[1] = __uint_as_float(w.z & 0xffff0000u); b[2] = __uint_as_float(w.w << 16); b[3] = __uint_as_float(w.w & 0xffff0000u);
}

#define E4M3_CLAMP(x) __builtin_amdgcn_fmed3f((x), -448.0f, 448.0f)
__device__ __forceinline__ uint2 pack8_fp8(const f32x4& a, const f32x4& b) {
    int lo = 0, hi = 0;
    lo = __builtin_amdgcn_cvt_pk_fp8_f32(E4M3_CLAMP(a[0]), E4M3_CLAMP(a[1]), lo, false); lo = __builtin_amdgcn_cvt_pk_fp8_f32(E4M3_CLAMP(a[2]), E4M3_CLAMP(a[3]), lo, true);
    hi = __builtin_amdgcn_cvt_pk_fp8_f32(E4M3_CLAMP(b[0]), E4M3_CLAMP(b[1]), hi, false); hi = __builtin_amdgcn_cvt_pk_fp8_f32(E4M3_CLAMP(b[2]), E4M3_CLAMP(b[3]), hi, true);
    return make_uint2((unsigned)lo, (unsigned)hi);
}
struct EpiInProj {
    static constexpr bool PERM = true, AFTER_DRAIN = false;
    bf16_t* projr; bf16_t* kvc; const PG8_LAS float* rst; const unsigned* tab;
    __device__ __forceinline__ void operator()(const f32x4 (&acc)[2][2][4][2], const Unit& u, int wr, int wc, int fr, int fq) const {
        const int rl0 = wr * 64 + fr, row0 = u.pm * BM + rl0, pn = u.pn;
        const PG8_LAS float* rsu = rst + u.ui * 256 + rl0;
        if (pn >= 9) {
            const int col0 = (pn - 9) * 256 + wc * 32 + 8 * fq;
#pragma unroll
            for (int ai = 0; ai < 2; ++ai)
#pragma unroll
                for (int m = 0; m < 4; ++m) { const int r = row0 - 32768 + ai * HALF + m * 16; const float rs = rsu[ai * HALF + m * 16];
#pragma unroll
                    for (int bj = 0; bj < 2; ++bj) *(u32x4v*)(kvc + (size_t)r * 2112 + col0 + bj * HALF) = pack8(acc[ai][bj][m][0] * rs, acc[ai][bj][m][1] * rs); }
        } else if (pn == 4 || pn == 5 || (pn == 8 && wc >= 2)) {
            const int c0 = (pn == 8) ? (2176 + (wc - 2) * 32 + 8 * fq) : (1024 + (pn - 4) * 256 + wc * 32 + 8 * fq), cstep = (pn == 8) ? 64 : 128;
#pragma unroll
            for (int ai = 0; ai < 2; ++ai)
#pragma unroll
                for (int m = 0; m < 4; ++m) { const int r = row0 + ai * HALF + m * 16; const float rs = rsu[ai * HALF + m * 16];
#pragma unroll
                    for (int bj = 0; bj < 2; ++bj) *(u32x4v*)(projr + (size_t)r * 2304 + c0 + bj * cstep) = pack8(acc[ai][bj][m][0] * rs, acc[ai][bj][m][1] * rs); }
        } else {
            int cb; float sc = 1.0f;
            if (pn < 2) { cb = pn * 256; sc = 0.125f * 1.4426950408889634f; } else if (pn < 4) { cb = 512 + (pn - 2) * 256; } else if (pn < 8) { cb = 1536 + (pn - 6) * 256; sc = 0.125f * 1.4426950408889634f; } else { cb = 2048; }
            const int c0 = cb + wc * 64 + 8 * fq;
#pragma unroll
            for (int ai = 0; ai < 2; ++ai) {
                u32x4v tw[4][2];
#pragma unroll
                for (int m = 0; m < 4; ++m) { const u32x4v* tp = (const u32x4v*)(tab + (size_t)(row0 + ai * HALF + m * 16) * 32 + 8 * fq); tw[m][0] = tp[0]; tw[m][1] = tp[1]; }
#pragma unroll
                for (int m = 0; m < 4; ++m) { const int r = row0 + ai * HALF + m * 16; const float rs = rsu[ai * HALF + m * 16] * sc;
                    const u32x4v ta = tw[m][0], tb = tw[m][1];
                    const f32x4 cA = {__uint_as_float(ta.x << 16), __uint_as_float(ta.y << 16), __uint_as_float(ta.z << 16), __uint_as_float(ta.w << 16)};
                    const f32x4 sA = {__uint_as_float(ta.x & 0xffff0000u), __uint_as_float(ta.y & 0xffff0000u), __uint_as_float(ta.z & 0xffff0000u), __uint_as_float(ta.w & 0xffff0000u)};
                    const f32x4 cB = {__uint_as_float(tb.x << 16), __uint_as_float(tb.y << 16), __uint_as_float(tb.z << 16), __uint_as_float(tb.w << 16)};
                    const f32x4 sB = {__uint_as_float(tb.x & 0xffff0000u), __uint_as_float(tb.y & 0xffff0000u), __uint_as_float(tb.z & 0xffff0000u), __uint_as_float(tb.w & 0xffff0000u)};
                    const f32x4 x1a = acc[ai][0][m][0] * rs, x1b = acc[ai][0][m][1] * rs, x2a = acc[ai][1][m][0] * rs, x2b = acc[ai][1][m][1] * rs;
                    *(u32x4v*)(projr + (size_t)r * 2304 + c0) = pack8(x1a * cA - x2a * sA, x1b * cB - x2b * sB);
                    *(u32x4v*)(projr + (size_t)r * 2304 + c0 + 32) = pack8(x2a * cA + x1a * sA, x2b * cB + x1b * sB); }
            }
        }
    }
};
struct EpiRes {
    static constexpr bool PERM = true, AFTER_DRAIN = false;
    const bf16_t* res; bf16_t* out; float* ssp; unsigned char* out8; float asc; int p8;
    __device__ __forceinline__ void operator()(const f32x4 (&acc)[2][2][4][2], const Unit& u, int wr, int wc, int fr, int fq) const {
        const int row0 = u.pm * BM + wr * 64 + fr, col0 = u.pn * BM + wc * 32 + 8 * fq;
        u32x4v rv[4][2], ov[4][2]; uint2 o8[4][2]; float sv[4];
#define ER_LOAD(ai) do { _Pragma("unroll") for (int m = 0; m < 4; ++m) _Pragma("unroll") for (int bj = 0; bj < 2; ++bj) rv[m][bj] = *(const u32x4v*)(res + (size_t)(row0 + (ai) * HALF + m * 16) * 1024 + col0 + bj * HALF); } while (0)
#define ER_CALC(ai) do { _Pragma("unroll") for (int m = 0; m < 4; ++m) { float ss = 0.f; \
            _Pragma("unroll") for (int bj = 0; bj < 2; ++bj) { f32x4 ra, rb; unpack8(rv[m][bj], ra, rb); const f32x4 va = acc[ai][bj][m][0] * asc + ra, vb = acc[ai][bj][m][1] * asc + rb; \
                ss += (va[0] * va[0] + va[1] * va[1]) + (va[2] * va[2] + va[3] * va[3]) + (vb[0] * vb[0] + vb[1] * vb[1]) + (vb[2] * vb[2] + vb[3] * vb[3]); ov[m][bj] = pack8(va, vb); if (out8) o8[m][bj] = pack8_fp8(va, vb); } \
            ss += __shfl_xor(ss, 16); ss += __shfl_xor(ss, 32); sv[m] = ss; } } while (0)
#define ER_STORE(ai) do { _Pragma("unroll") for (int m = 0; m < 4; ++m) { const int r = row0 + (ai) * HALF + m * 16; \
            _Pragma("unroll") for (int bj = 0; bj < 2; ++bj) { *(u32x4v*)(out + (size_t)r * 1024 + col0 + bj * HALF) = ov[m][bj]; if (out8) *(uint2*)(out8 + (size_t)r * p8 + col0 + bj * HALF) = o8[m][bj]; } \
            if (fq == 0) ssp[(size_t)r * 16 + u.pn * 4 + wc] = sv[m]; } } while (0)
        ER_LOAD(0); ER_CALC(0); ER_LOAD(1); ER_STORE(0); ER_CALC(1); ER_STORE(1);
#undef ER_LOAD
#undef ER_CALC
#undef ER_STORE
    }
};
__device__ __forceinline__ float rstd_from_ssp(const float* ssp, int r) {
    const f32x4* p = (const f32x4*)(ssp + (size_t)r * 16); const f32x4 a = p[0], b = p[1], c = p[2], d = p[3];
    const float s = ((a[0] + a[1]) + (a[2] + a[3])) + ((b[0] + b[1]) + (b[2] + b[3])) + ((c[0] + c[1]) + (c[2] + c[3])) + ((d[0] + d[1]) + (d[2] + d[3]));
    return rsqrtf(s * (1.0f / 1024.0f) + 1e-6f);
}
struct EpiScale {
    static constexpr bool PERM = true, AFTER_DRAIN = false;
    bf16_t* out; const PG8_LAS float* rst;
    __device__ __forceinline__ void operator()(const f32x4 (&acc)[2][2][4][2], const Unit& u, int wr, int wc, int fr, int fq) const {
        const int rl0 = wr * 64 + fr, row0 = u.pm * BM + rl0, col0 = u.pn * BM + wc * 32 + 8 * fq;
#pragma unroll
        for (int ai = 0; ai < 2; ++ai)
#pragma unroll
            for (int m = 0; m < 4; ++m) { const int r = row0 + ai * HALF + m * 16; const float rs = rst[u.ui * 256 + rl0 + ai * HALF + m * 16];
#pragma unroll
                for (int bj = 0; bj < 2; ++bj) *(u32x4v*)(out + (size_t)r * 1024 + col0 + bj * HALF) = pack8(acc[ai][bj][m][0] * rs, acc[ai][bj][m][1] * rs); }
    }
};
struct EpiGateUp {
    static constexpr bool PERM = true, AFTER_DRAIN = false;
    unsigned char* hdn; const PG8_LAS float* rst;
    __device__ __forceinline__ void operator()(const f32x4 (&acc)[2][2][4][2], const Unit& u, int wr, int wc, int fr, int fq) const {
        const int rl0 = wr * 64 + fr, col0 = (u.pn & 3) * 128 + wc * 32 + 8 * fq;
#pragma unroll
        for (int ai = 0; ai < 2; ++ai)
#pragma unroll
            for (int m = 0; m < 4; ++m) { const int rl = rl0 + ai * HALF + m * 16; const float rs = rst[u.ui * 256 + rl] * (1.0f / 64.0f);
                f32x4 h[2];
#pragma unroll
                for (int n = 0; n < 2; ++n) { const f32x4 g = acc[ai][0][m][n] * rs, up = acc[ai][1][m][n] * rs;
#pragma unroll
                    for (int j = 0; j < 4; ++j) h[n][j] = g[j] * __builtin_amdgcn_rcpf(1.0f + __builtin_amdgcn_exp2f(-1.4426950408889634f * g[j])) * up[j]; }
                *(uint2*)(hdn + (size_t)(u.pm * BM + rl) * 512 + col0) = pack8_fp8(h[0] * 8.0f, h[1] * 8.0f); }
    }
};
struct EpiDown {
    static constexpr bool PERM = true, AFTER_DRAIN = false;
    unsigned char* y;
    __device__ __forceinline__ void operator()(const f32x4 (&acc)[2][2][4][2], const Unit& u, int wr, int wc, int fr, int fq) const {
        const int row0 = u.pm * BM + wr * 64 + fr, col0 = (u.pn & 3) * BM + wc * 32 + 8 * fq;
#pragma unroll
        for (int ai = 0; ai < 2; ++ai)
#pragma unroll
            for (int m = 0; m < 4; ++m) { const int r = row0 + ai * HALF + m * 16;
#pragma unroll
                for (int bj = 0; bj < 2; ++bj) *(uint2*)(y + (size_t)r * 1024 + col0 + bj * HALF) = pack8_fp8(acc[ai][bj][m][0] * (1.0f / 16.0f), acc[ai][bj][m][1] * (1.0f / 16.0f)); }
    }
};
}


namespace att {
#define ALAS __attribute__((address_space(3)))
typedef short bf16x8 __attribute__((ext_vector_type(8)));
typedef short s16x4 __attribute__((ext_vector_type(4)));
typedef float f32x16 __attribute__((ext_vector_type(16)));
typedef unsigned u32x4 __attribute__((ext_vector_type(4)));
typedef float f32x2_t __attribute__((ext_vector_type(2)));
typedef __bf16 bf16x2_t __attribute__((ext_vector_type(2)));
typedef short v4i16_t __attribute__((ext_vector_type(4)));
__device__ __forceinline__ unsigned cvtpk(float lo, float hi) { f32x2_t v = {lo, hi}; bf16x2_t b = __builtin_convertvector(v, bf16x2_t); return __builtin_bit_cast(unsigned, b); }
__device__ __forceinline__ s16x4 vtr(const ALAS unsigned char* p) { return __builtin_bit_cast(s16x4, __builtin_amdgcn_ds_read_tr16_b64_v4i16((ALAS v4i16_t*)p)); }
__device__ __forceinline__ int crow(int r, int hi) { return (r & 3) + 8 * (r >> 2) + 4 * hi; }
__device__ __forceinline__ float amax3(float a, float b, float c) { float r; asm("v_max3_f32 %0, %1, %2, %3" : "=v"(r) : "v"(a), "v"(b), "v"(c)); return r; }
__device__ __forceinline__ float amax2(float a, float b) { float r; asm("v_max_f32_e32 %0, %1, %2" : "=v"(r) : "v"(a), "v"(b)); return r; }
__device__ __forceinline__ float xhalf_max(float x) { const auto rr = __builtin_amdgcn_permlane32_swap(__float_as_uint(x), __float_as_uint(x), false, false); return fmaxf(__uint_as_float(rr[0]), __uint_as_float(rr[1])); }
__device__ __forceinline__ float xhalf_sum(float x) { const auto rr = __builtin_amdgcn_permlane32_swap(__float_as_uint(x), __float_as_uint(x), false, false); return __uint_as_float(rr[0]) + __uint_as_float(rr[1]); }
template <int K> __device__ __forceinline__ float swz_xor(float x) { return __uint_as_float((unsigned)__builtin_amdgcn_ds_swizzle((int)__float_as_uint(x), (K << 10) | 0x1f)); }
__device__ __forceinline__ float aadd(float a, float b) { float r; asm("v_add_f32_e32 %0, %1, %2" : "=v"(r) : "v"(a), "v"(b)); return r; }
#define CROWC(r) (((r) & 3) + 8 * ((r) >> 2))
constexpr int SCR_OFF = 66560;
constexpr float THR = 8.0f;

}


namespace att {
__device__ __forceinline__ void diff_unit(ALAS unsigned char* lds, const bf16_t* __restrict__ projr, bf16_t* __restrict__ ocat, int b, int hh, int qb, float lam, const float* __restrict__ subln_w) {
    constexpr int KBB = 16384, VBB = 16384, VOFF = 32768, NDB = 4;
    const int tid = fresh_tid(), lane = tid & 63;
    const int r32 = lane & 31, hi = lane >> 5, w = __builtin_amdgcn_readfirstlane(tid >> 6);
    const int comp = w >> 2, qsub = w & 3;
    const int q0 = qb * 128 + qsub * 32;
    const size_t rowbase = (size_t)b * SEQ;
    const int t1 = 2 * qb + 2;
    bf16x8 qf[4];
#pragma unroll
    for (int d0 = 0; d0 < 4; ++d0) qf[d0] = *(const bf16x8*)(projr + (rowbase + q0 + r32) * INW + DQ0 + hh * 128 + comp * 64 + 16 * d0 + 8 * hi);
    const char* ksrc = (const char*)(projr + rowbase * INW + DK0 + hh * 128 + w * 8);
    const char* vsrc = (const char*)(projr + (rowbase + (w & 3) * 16) * INW + DV0 + hh * 128 + (w >> 2) * 32);
#define DF_KOFF ((unsigned)lane * (INW * 2))
#define DF_VOFF ((unsigned)(lane >> 2) * (INW * 2) + (unsigned)(lane & 3) * 16)
#define DF_DMAK(t) do { const char* _s = ksrc + (size_t)(t) * (64 * INW * 2); ALAS unsigned* _d = (ALAS unsigned*)(lds + ((t) & 1) * KBB + w * 1024); \
        __builtin_amdgcn_global_load_lds((const unsigned*)(_s + DF_KOFF), _d, 16, 0, 0); __builtin_amdgcn_global_load_lds((const unsigned*)(_s + 128 + DF_KOFF), _d + 2048, 16, 0, 0); } while (0)
#define DF_DMAV(t) do { const char* _s = vsrc + (size_t)(t) * (64 * INW * 2); ALAS unsigned* _d = (ALAS unsigned*)(lds + VOFF + ((t) & 1) * VBB + w * 1024); \
        __builtin_amdgcn_global_load_lds((const unsigned*)(_s + DF_VOFF), _d, 16, 0, 0); __builtin_amdgcn_global_load_lds((const unsigned*)(_s + 128 + DF_VOFF), _d + 2048, 16, 0, 0); } while (0)
    ALAS float* scr = (ALAS float*)(lds + SCR_OFF + w * 256);
    float m = 0.f, l = 0.f;
    f32x16 negm = f32x16{};
    f32x16 o[NDB];
#pragma unroll
    for (int d = 0; d < NDB; ++d) o[d] = f32x16{};
    const int kfrag = comp * 8192 + hi * 1024 + r32 * 16;
    const int vfrag = VOFF + ((lane >> 4) & 1) * 32 + (lane & 3) * 8 + (4 * hi + ((lane & 15) >> 2)) * 64;
#define DF_SBAR() __builtin_amdgcn_sched_barrier(0)
#define DF_QK1(S0, S1, t, d0) do { const ALAS unsigned char* _kb = lds + ((t) & 1) * KBB + kfrag + (d0) * 2048; const bf16x8 _k0 = *(const ALAS bf16x8*)(_kb), _k1 = *(const ALAS bf16x8*)(_kb + 512); \
        S0 = __builtin_amdgcn_mfma_f32_32x32x16_bf16(_k0, qf[d0], (d0) == 0 ? negm : S0, 0, 0, 0); S1 = __builtin_amdgcn_mfma_f32_32x32x16_bf16(_k1, qf[d0], (d0) == 0 ? negm : S1, 0, 0, 0); } while (0)
#define DF_PV1(PW, t, d) do { const ALAS unsigned char* _vb = lds + ((t) & 1) * VBB + vfrag + (d) * 4096; \
        _Pragma("unroll") for (int ks = 0; ks < 4; ++ks) { const s16x4 _lo = vtr(_vb + ks * 1024), _hi = vtr(_vb + ks * 1024 + 512); \
            const bf16x8 _vf = (bf16x8){_lo[0], _lo[1], _lo[2], _lo[3], _hi[0], _hi[1], _hi[2], _hi[3]}; \
            o[d] = __builtin_amdgcn_mfma_f32_32x32x16_bf16(__builtin_bit_cast(bf16x8, PW[ks]), _vf, o[d], 0, 0, 0); } } while (0)
#define DF_SM1(C0, C1, PW, i) do { C0[2 * (i)] = __builtin_amdgcn_exp2f(C0[2 * (i)]); C0[2 * (i) + 1] = __builtin_amdgcn_exp2f(C0[2 * (i) + 1]); \
        C1[2 * (i)] = __builtin_amdgcn_exp2f(C1[2 * (i)]); C1[2 * (i) + 1] = __builtin_amdgcn_exp2f(C1[2 * (i) + 1]); \
        lsum = aadd(lsum, aadd(aadd(C0[2 * (i)], C0[2 * (i) + 1]), aadd(C1[2 * (i)], C1[2 * (i) + 1]))); \
        PW[(i) >> 2][(i) & 3] = cvtpk(C0[2 * (i)], C0[2 * (i) + 1]); PW[2 + ((i) >> 2)][(i) & 3] = cvtpk(C1[2 * (i)], C1[2 * (i) + 1]); } while (0)
#define DF_QK(S0, S1, t) do { DF_SBAR(); DF_QK1(S0, S1, t, 0); DF_SBAR(); DF_QK1(S0, S1, t, 1); DF_SBAR(); DF_QK1(S0, S1, t, 2); DF_SBAR(); DF_QK1(S0, S1, t, 3); DF_SBAR(); } while (0)
#define DF_PV(PW, t) do { DF_SBAR(); DF_PV1(PW, t, 0); DF_SBAR(); DF_PV1(PW, t, 1); DF_SBAR(); DF_PV1(PW, t, 2); DF_SBAR(); DF_PV1(PW, t, 3); DF_SBAR(); } while (0)
#define DF_MAX(C0, C1, mx) do { mx = fmaxf(C0[0], C1[0]); _Pragma("unroll") for (int r = 1; r < 16; ++r) mx = fmaxf(mx, fmaxf(C0[r], C1[r])); mx = xhalf_max(mx); } while (0)
#define DF_RESCALE(C0, C1, dl) do { const float _dl = (dl), _al = __builtin_amdgcn_exp2f(-_dl); m += _dl; l *= _al; scr[r32] = _al; \
        _Pragma("unroll") for (int r = 0; r < 16; ++r) { const float _a = scr[4 * hi + CROWC(r)]; _Pragma("unroll") for (int d = 0; d < NDB; ++d) o[d][r] *= _a; } \
        _Pragma("unroll") for (int r = 0; r < 16; ++r) { C0[r] -= _dl; C1[r] -= _dl; negm[r] = -m; } } while (0)
#define DF_SOFTMAX(C0, C1, PW) do { float _ls = 0.f; \
        _Pragma("unroll") for (int r = 0; r < 16; ++r) { C0[r] = __builtin_amdgcn_exp2f(C0[r]); C1[r] = __builtin_amdgcn_exp2f(C1[r]); _ls += C0[r] + C1[r]; } \
        l += _ls; \
        _Pragma("unroll") for (int s = 0; s < 2; ++s) { \
            PW[s]     = (u32x4){cvtpk(C0[8 * s], C0[8 * s + 1]), cvtpk(C0[8 * s + 2], C0[8 * s + 3]), cvtpk(C0[8 * s + 4], C0[8 * s + 5]), cvtpk(C0[8 * s + 6], C0[8 * s + 7])}; \
            PW[2 + s] = (u32x4){cvtpk(C1[8 * s], C1[8 * s + 1]), cvtpk(C1[8 * s + 2], C1[8 * s + 3]), cvtpk(C1[8 * s + 4], C1[8 * s + 5]), cvtpk(C1[8 * s + 6], C1[8 * s + 7])}; } } while (0)
#define DF_KLD(F, t, d0) do { const ALAS unsigned char* _kb = lds + ((t) & 1) * KBB + kfrag + (d0) * 2048; F[0] = *(const ALAS bf16x8*)(_kb); F[1] = *(const ALAS bf16x8*)(_kb + 512); } while (0)
#define DF_VLD(F, t, d, kp) do { const ALAS unsigned char* _vb = lds + ((t) & 1) * VBB + vfrag + (d) * 4096 + (kp) * 2048; \
        _Pragma("unroll") for (int k2 = 0; k2 < 2; ++k2) { const s16x4 _lo = vtr(_vb + k2 * 1024), _hi = vtr(_vb + k2 * 1024 + 512); F[k2] = (bf16x8){_lo[0], _lo[1], _lo[2], _lo[3], _hi[0], _hi[1], _hi[2], _hi[3]}; } } while (0)
#define DF_QKM(S0, S1, F, d0) do { S0 = __builtin_amdgcn_mfma_f32_32x32x16_bf16(F[0], qf[d0], (d0) == 0 ? negm : S0, 0, 0, 0); S1 = __builtin_amdgcn_mfma_f32_32x32x16_bf16(F[1], qf[d0], (d0) == 0 ? negm : S1, 0, 0, 0); } while (0)
#define DF_PVM(PW, F, d, kp) do { o[d] = __builtin_amdgcn_mfma_f32_32x32x16_bf16(__builtin_bit_cast(bf16x8, PW[2 * (kp)]), F[0], o[d], 0, 0, 0); \
        o[d] = __builtin_amdgcn_mfma_f32_32x32x16_bf16(__builtin_bit_cast(bf16x8, PW[2 * (kp) + 1]), F[1], o[d], 0, 0, 0); } while (0)
#define DF_MAX8(mx, S, b0) amax3(amax3(amax3(amax3(mx, S[b0], S[b0 + 1]), S[b0 + 2], S[b0 + 3]), S[b0 + 4], S[b0 + 5]), S[b0 + 6], S[b0 + 7])
#define DF_STEP_FAST(C0, C1, N0, N1, PWO, PWN, t) do { \
        DF_DMAK((t) + 2); DF_DMAV(t); \
        bf16x8 fa[2], fb[2]; \
        DF_KLD(fa, (t) + 1, 0); \
        if (__any(mxc > THR)) { DF_PV(PWO, (t) - 1); PWO[0] = (u32x4){0u, 0u, 0u, 0u}; PWO[1] = PWO[0]; PWO[2] = PWO[0]; PWO[3] = PWO[0]; DF_RESCALE(C0, C1, fmaxf(mxc, 0.f)); } \
        float lsum = 0.f, mxa; DF_SBAR(); \
        DF_KLD(fb, (t) + 1, 1); DF_QKM(N0, N1, fa, 0); DF_SM1(C0, C1, PWN, 0); DF_SBAR(); \
        DF_KLD(fa, (t) + 1, 2); DF_QKM(N0, N1, fb, 1); DF_SM1(C0, C1, PWN, 1); DF_SBAR(); \
        DF_KLD(fb, (t) + 1, 3); DF_QKM(N0, N1, fa, 2); DF_SM1(C0, C1, PWN, 2); DF_SBAR(); \
        DF_VLD(fa, (t) - 1, 0, 0); DF_QKM(N0, N1, fb, 3); DF_SM1(C0, C1, PWN, 3); DF_SBAR(); \
        DF_VLD(fb, (t) - 1, 0, 1); DF_PVM(PWO, fa, 0, 0); DF_SM1(C0, C1, PWN, 4); DF_SBAR(); \
        DF_VLD(fa, (t) - 1, 1, 0); DF_PVM(PWO, fb, 0, 1); DF_SM1(C0, C1, PWN, 5); DF_SBAR(); \
        DF_VLD(fb, (t) - 1, 1, 1); DF_PVM(PWO, fa, 1, 0); DF_SM1(C0, C1, PWN, 6); DF_SBAR(); \
        DF_VLD(fa, (t) - 1, 2, 0); DF_PVM(PWO, fb, 1, 1); DF_SM1(C0, C1, PWN, 7); DF_SBAR(); \
        DF_VLD(fb, (t) - 1, 2, 1); DF_PVM(PWO, fa, 2, 0); mxa = DF_MAX8(N0[0], N0, 0); DF_SBAR(); \
        DF_VLD(fa, (t) - 1, 3, 0); DF_PVM(PWO, fb, 2, 1); mxa = DF_MAX8(mxa, N1, 0); DF_SBAR(); \
        DF_VLD(fb, (t) - 1, 3, 1); DF_PVM(PWO, fa, 3, 0); mxa = DF_MAX8(mxa, N0, 8); DF_SBAR(); \
        DF_PVM(PWO, fb, 3, 1); mxa = DF_MAX8(mxa, N1, 8); mxc = xhalf_max(mxa); DF_SBAR(); \
        l += lsum; \
        __syncthreads(); } while (0)
#define DF_STEP_GEN(C0, C1, N0, N1, PWO, PWN, t) do { \
        if ((t) + 2 < t1) DF_DMAK((t) + 2); \
        DF_DMAV(t); \
        const int _kv0 = (t) * 64; const bool _act = _kv0 <= q0 + 31, _actn = ((t) + 1 < t1) && (_kv0 + 64 <= q0 + 31); \
        if (_act) { \
            if (_kv0 + 63 > q0) { const int _qr = q0 + r32 - _kv0 - 4 * hi; _Pragma("unroll") for (int r = 0; r < 16; ++r) { if (CROWC(r) > _qr) C0[r] = -INFINITY; if (CROWC(r) + 32 > _qr) C1[r] = -INFINITY; } } \
            float _mx; DF_MAX(C0, C1, _mx); \
            if ((t) == 0) { m = _mx; _Pragma("unroll") for (int r = 0; r < 16; ++r) { C0[r] -= _mx; C1[r] -= _mx; negm[r] = -_mx; } }     \
            else if (__any(_mx > THR)) { if (pend) { DF_PV(PWO, (t) - 1); pend = false; } DF_RESCALE(C0, C1, fmaxf(_mx, 0.f)); } } \
        if (_actn) { DF_QK(N0, N1, (t) + 1); DF_MAX(N0, N1, mxc); } \
        if (pend) DF_PV(PWO, (t) - 1); \
        pend = false; \
        if (_act) { DF_SOFTMAX(C0, C1, PWN); pend = true; } \
        __syncthreads(); } while (0)

    f32x16 sa0, sa1, sb0, sb1; u32x4 pa[4], pb[4];
    bool pend = false; float mxc = 0.f;
    DF_DMAK(0); DF_DMAK(1);
    __syncthreads();
    DF_QK(sa0, sa1, 0);
    DF_STEP_GEN(sa0, sa1, sb0, sb1, pb, pa, 0);
    DF_STEP_GEN(sb0, sb1, sa0, sa1, pa, pb, 1);
    int t = 2;
    for (; t + 2 < t1; t += 2) {
        DF_STEP_FAST(sa0, sa1, sb0, sb1, pb, pa, t);
        DF_STEP_FAST(sb0, sb1, sa0, sa1, pa, pb, t + 1);
    }
    if (t < t1) {
        DF_STEP_GEN(sa0, sa1, sb0, sb1, pb, pa, t);
        DF_STEP_GEN(sb0, sb1, sa0, sa1, pa, pb, t + 1);
    }
    if (pend) DF_PV(pb, t1 - 1);
#undef DF_DMAK
#undef DF_KOFF
#undef DF_VOFF
#undef DF_KLD
#undef DF_VLD
#undef DF_QKM
#undef DF_PVM
#undef DF_MAX8
#undef DF_DMAV
#undef DF_SBAR
#undef DF_QK1
#undef DF_PV1
#undef DF_SM1
#undef DF_QK
#undef DF_PV
#undef DF_MAX
#undef DF_RESCALE
#undef DF_SOFTMAX
#undef DF_STEP_FAST
#undef DF_STEP_GEN
    l = xhalf_sum(l);
    scr[32 + r32] = l;
    float inv[16];
#pragma unroll
    for (int r = 0; r < 16; ++r) inv[r] = 1.0f / scr[32 + 4 * hi + CROWC(r)];
    const size_t orow0 = rowbase + q0;
    __syncthreads();
    ALAS float* ex = (ALAS float*)(lds + (w & 3) * 16384);
    if (w >= 4) {
#pragma unroll
        for (int d = 0; d < NDB; ++d)
#pragma unroll
            for (int r = 0; r < 16; ++r) ex[(d * 16 + r) * 64 + lane] = o[d][r] * inv[r];
    }
    __syncthreads();
    if (w < 4) {
        ALAS unsigned char* stg = lds + 69632 + w * 8192;
        float sw[NDB];
#pragma unroll
        for (int d = 0; d < NDB; ++d) sw[d] = subln_w[d * 32 + r32] * (1.0f - LAMBDA_INIT);
#pragma unroll
        for (int r = 0; r < 16; ++r) {
            float v[NDB]; float ss = 0.f;
#pragma unroll
            for (int d = 0; d < NDB; ++d) { v[d] = o[d][r] * inv[r] - lam * ex[(d * 16 + r) * 64 + lane]; ss += v[d] * v[d]; }
            ss += swz_xor<1>(ss); ss += swz_xor<2>(ss); ss += swz_xor<4>(ss); ss += swz_xor<8>(ss); ss += swz_xor<16>(ss);
            const float rn = rsqrtf(ss * (1.0f / 128.0f) + EPS);
#pragma unroll
            for (int d = 0; d < NDB; ++d) *(ALAS bf16_t*)(stg + (4 * hi + CROWC(r)) * 256 + (d * 32 + r32) * 2) = f2bf(v[d] * rn * sw[d]);
        }
        bf16_t* ob = ocat + orow0 * DM + hh * 128;
#pragma unroll
        for (int i = 0; i < 8; ++i) { const int idx = i * 64 + lane, row = idx >> 4, ch = idx & 15;
            *(u32x4*)(ob + (size_t)row * DM + ch * 8) = *(const ALAS u32x4*)(stg + row * 256 + ch * 16); }
    }
    __syncthreads();
}
}

namespace att {
constexpr int CR_SCR = 131072 + 14336;
template <class Sched>
__device__ __forceinline__ void cross_phase(ALAS unsigned char* lds, const bf16_t* __restrict__ qc, const bf16_t* __restrict__ kvc, unsigned char* __restrict__ oc, int ocp, const Sched& S) {
    const int tid = fresh_tid(), w = __builtin_amdgcn_readfirstlane(tid >> 6);
    int lane = tid & 63;
    int r32 = lane & 31, hi = lane >> 5;
    unsigned koff = (unsigned)lane * (2112u * 2u), voff = (unsigned)(lane >> 2) * (2112u * 2u) + (unsigned)(lane & 3) * 16u;
    ALAS float* scr = (ALAS float*)(lds + CR_SCR + w * 256);
    pg8::Unit u, un;
    if (!S.next(0, u)) return;
#define CR_KSRC(uu) ((const char*)(kvc + (size_t)((uu).pm >> 4) * MEML * 2112 + (uu).pn * 256 + w * 8))
#define CR_VSRC(uu) ((const char*)(kvc + ((size_t)((uu).pm >> 4) * MEML + (w & 3) * 16) * 2112 + 1024 + (uu).pn * 256 + (w >> 2) * 32))
#define CR_QP(uu) (qc + ((size_t)(uu).pm * 256 + w * 32 + r32) * DM + (uu).pn * 256 + 8 * hi)
#define CR_DMAK(uu, dc, bo) do { const char* _s = CR_KSRC(uu) + (dc) * 128; _Pragma("unroll") for (int _i = 0; _i < 4; ++_i) \
        __builtin_amdgcn_global_load_lds((const unsigned*)(_s + (size_t)_i * (64 * 2112 * 2) + koff), (ALAS unsigned*)(lds + (bo) + (w * 256 + _i * 64) * 16), 16, 0, 0); } while (0)
#define CR_DMAV(uu, kc, bo) do { const char* _s = CR_VSRC(uu) + (size_t)(kc) * (64 * 2112 * 2); _Pragma("unroll") for (int _i = 0; _i < 4; ++_i) \
        __builtin_amdgcn_global_load_lds((const unsigned*)(_s + _i * 128 + voff), (ALAS unsigned*)(lds + (bo) + (w + 8 * _i) * 1024), 16, 0, 0); } while (0)
#define CR_SBAR() __builtin_amdgcn_sched_barrier(0)
#define CR_ENDSTAGE(iss) do { if (iss) asm volatile("s_waitcnt vmcnt(4) lgkmcnt(0)" ::: "memory"); else asm volatile("s_waitcnt vmcnt(0) lgkmcnt(0)" ::: "memory"); \
        __builtin_amdgcn_s_barrier(); asm volatile("" ::: "memory"); { const int _t = bA; bA = bB; bB = bC; bC = _t; } } while (0)
    int bA = 0, bB = 32768, bC = 65536;
    ALAS unsigned char* stg = lds + 98304 + w * 4096;
    bf16x8 qf[4], qn[4];
    { const bf16_t* qp = CR_QP(u);
#pragma unroll
      for (int d0 = 0; d0 < 4; ++d0) qf[d0] = *(const bf16x8*)(qp + 16 * d0); }
    CR_DMAK(u, 0, bA); CR_DMAK(u, 1, bB);
    asm volatile("s_waitcnt vmcnt(4)" ::: "memory"); __builtin_amdgcn_s_barrier(); asm volatile("" ::: "memory");
#pragma unroll 1
    for (int ui = 0;; ++ui) {
        const bool has_next = S.next(ui + 1, un);
        asm volatile("" : "+v"(lane));
        r32 = lane & 31; hi = lane >> 5; koff = (unsigned)lane * (2112u * 2u); voff = (unsigned)(lane >> 2) * (2112u * 2u) + (unsigned)(lane & 3) * 16u;
        const int vfrag = ((lane >> 4) & 1) * 32 + (lane & 3) * 8 + (4 * hi + ((lane & 15) >> 2)) * 64;
        const bf16_t* qp = CR_QP(u);
        f32x16 s[8];
#pragma unroll
        for (int kb = 0; kb < 8; ++kb) s[kb] = f32x16{};
#pragma unroll
        for (int dc = 0; dc < 4; ++dc) {
            if (dc < 3) {
#pragma unroll
                for (int d0 = 0; d0 < 4; ++d0) qn[d0] = *(const bf16x8*)(qp + (dc + 1) * 64 + 16 * d0);
            }
            if (dc < 2) CR_DMAK(u, dc + 2, bC); else CR_DMAV(u, dc - 2, bC);
            const ALAS unsigned char* kbase = lds + bA + (hi * 256 + r32) * 16;
            bf16x8 fa[2], fb[2];
#define CR_KLD(F, g) do { _Pragma("unroll") for (int k2 = 0; k2 < 2; ++k2) F[k2] = *(const ALAS bf16x8*)(kbase + (2 * (2 * ((g) & 1) + k2) * 256 + ((g) >> 1) * 32) * 16); } while (0)
#define CR_KMM(F, g) do { _Pragma("unroll") for (int k2 = 0; k2 < 2; ++k2) s[(g) >> 1] = __builtin_amdgcn_mfma_f32_32x32x16_bf16(F[k2], qf[2 * ((g) & 1) + k2], s[(g) >> 1], 0, 0, 0); } while (0)
            CR_KLD(fa, 0); CR_SBAR();
            CR_KLD(fb, 1); CR_KMM(fa, 0); CR_SBAR();
            CR_KLD(fa, 2); CR_KMM(fb, 1); CR_SBAR();
            CR_KLD(fb, 3); CR_KMM(fa, 2); CR_SBAR();
            CR_KLD(fa, 4); CR_KMM(fb, 3); CR_SBAR();
            CR_KLD(fb, 5); CR_KMM(fa, 4); CR_SBAR();
            CR_KLD(fa, 6); CR_KMM(fb, 5); CR_SBAR();
            CR_KLD(fb, 7); CR_KMM(fa, 6); CR_SBAR();
            CR_KLD(fa, 8); CR_KMM(fb, 7); CR_SBAR();
            CR_KLD(fb, 9); CR_KMM(fa, 8); CR_SBAR();
            CR_KLD(fa, 10); CR_KMM(fb, 9); CR_SBAR();
            CR_KLD(fb, 11); CR_KMM(fa, 10); CR_SBAR();
            CR_KLD(fa, 12); CR_KMM(fb, 11); CR_SBAR();
            CR_KLD(fb, 13); CR_KMM(fa, 12); CR_SBAR();
            CR_KLD(fa, 14); CR_KMM(fb, 13); CR_SBAR();
            CR_KLD(fb, 15); CR_KMM(fa, 14); CR_SBAR();
            CR_KMM(fb, 15); CR_SBAR();
#undef CR_KLD
#undef CR_KMM
            if (dc < 3) {
#pragma unroll
                for (int d0 = 0; d0 < 4; ++d0) qf[d0] = qn[d0];
            }
            CR_ENDSTAGE(true);
        }
        float mx = s[0][0];
#pragma unroll
        for (int kb = 0; kb < 8; ++kb)
#pragma unroll
            for (int r = 0; r < 16; ++r) mx = fmaxf(mx, s[kb][r]);
        mx = fmaxf(mx, __shfl_xor(mx, 32));
        float l = 0.f;
        u32x4 pw[16];
#pragma unroll
        for (int kb = 0; kb < 8; ++kb) {
#pragma unroll
            for (int r = 0; r < 16; ++r) { s[kb][r] = __builtin_amdgcn_exp2f(s[kb][r] - mx); l += s[kb][r]; }
#pragma unroll
            for (int s2 = 0; s2 < 2; ++s2)
                pw[kb * 2 + s2] = (u32x4){cvtpk(s[kb][8 * s2], s[kb][8 * s2 + 1]), cvtpk(s[kb][8 * s2 + 2], s[kb][8 * s2 + 3]), cvtpk(s[kb][8 * s2 + 4], s[kb][8 * s2 + 5]), cvtpk(s[kb][8 * s2 + 6], s[kb][8 * s2 + 7])};
        }
        l += __shfl_xor(l, 32);
        scr[r32] = l;
#pragma unroll
        for (int dh = 0; dh < 2; ++dh) {
            f32x16 o[4];
#pragma unroll
            for (int d = 0; d < 4; ++d) o[d] = f32x16{};
#pragma unroll
            for (int kc = 0; kc < 4; ++kc) {
                const int st = 4 + dh * 4 + kc;
                bool issued = true;
                if (st + 2 < 8) CR_DMAV(u, st + 2 - 4, bC); else if (st + 2 < 12) CR_DMAV(u, st + 2 - 8, bC); else if (has_next) CR_DMAK(un, st + 2 - 12, bC); else issued = false;
                const ALAS unsigned char* vb = lds + bA + vfrag + dh * 16384;
                bf16x8 fa[2], fb[2];
#define CR_VLD(F, g) do { _Pragma("unroll") for (int k2 = 0; k2 < 2; ++k2) { const s16x4 _lo = vtr(vb + ((g) >> 1) * 4096 + ((g) & 1) * 2048 + k2 * 1024), _hi = vtr(vb + ((g) >> 1) * 4096 + ((g) & 1) * 2048 + k2 * 1024 + 512); \
                F[k2] = (bf16x8){_lo[0], _lo[1], _lo[2], _lo[3], _hi[0], _hi[1], _hi[2], _hi[3]}; } } while (0)
#define CR_VMM(F, g) do { _Pragma("unroll") for (int k2 = 0; k2 < 2; ++k2) \
                o[(g) >> 1] = __builtin_amdgcn_mfma_f32_32x32x16_bf16(__builtin_bit_cast(bf16x8, pw[(2 * kc + ((g) & 1)) * 2 + k2]), F[k2], o[(g) >> 1], 0, 0, 0); } while (0)
                CR_VLD(fa, 0); CR_SBAR();
                CR_VLD(fb, 1); CR_VMM(fa, 0); CR_SBAR();
                CR_VLD(fa, 2); CR_VMM(fb, 1); CR_SBAR();
                CR_VLD(fb, 3); CR_VMM(fa, 2); CR_SBAR();
                CR_VLD(fa, 4); CR_VMM(fb, 3); CR_SBAR();
                CR_VLD(fb, 5); CR_VMM(fa, 4); CR_SBAR();
                CR_VLD(fa, 6); CR_VMM(fb, 5); CR_SBAR();
                CR_VLD(fb, 7); CR_VMM(fa, 6); CR_SBAR();
                CR_VMM(fb, 7); CR_SBAR();
#undef CR_VLD
#undef CR_VMM
                CR_ENDSTAGE(issued);
            }
            if (dh == 1 && has_next) { const bf16_t* qpn = CR_QP(un);
#pragma unroll
                for (int d0 = 0; d0 < 4; ++d0) qn[d0] = *(const bf16x8*)(qpn + 16 * d0); }
            float inv[16];
#pragma unroll
            for (int r = 0; r < 16; ++r) inv[r] = 16.0f / scr[4 * hi + CROWC(r)];
#pragma unroll
            for (int r = 0; r < 16; ++r)
#pragma unroll
                for (int d = 0; d < 4; ++d) *(ALAS unsigned char*)(stg + (4 * hi + CROWC(r)) * 128 + d * 32 + r32) = (unsigned char)__builtin_amdgcn_cvt_pk_fp8_f32(__builtin_amdgcn_fmed3f(o[d][r] * inv[r], -448.0f, 448.0f), 0.f, 0, false);
            unsigned char* ob = oc + ((size_t)u.pm * 256 + w * 32) * ocp + u.pn * 256 + dh * 128;
#pragma unroll
            for (int i = 0; i < 4; ++i) { const int idx = i * 64 + lane, row = idx >> 3, ch = idx & 7;
                *(u32x4*)(ob + (size_t)row * ocp + ch * 16) = *(const ALAS u32x4*)(stg + row * 128 + ch * 16); }
        }
        if (!has_next) break;
        u = un;
#pragma unroll
        for (int d0 = 0; d0 < 4; ++d0) qf[d0] = qn[d0];
    }
#undef CR_KSRC
#undef CR_VSRC
#undef CR_QP
#undef CR_DMAK
#undef CR_DMAV
#undef CR_SBAR
#undef CR_ENDSTAGE
}
}


namespace att {
template <class F>
__device__ __forceinline__ void swa_phase(ALAS unsigned char* lds, const bf16_t* __restrict__ projr, bf16_t* __restrict__ ocat, const float* __restrict__ sinks, int first, int stride, int count, F unit_of) {
    const int tid = fresh_tid(), w = __builtin_amdgcn_readfirstlane(tid >> 6);
    int lane = tid & 63;
    const int g = w >> 1, qsub = w & 1;
    ALAS float* scr = (ALAS float*)(lds + CR_SCR + w * 256);
    ALAS unsigned char* stg = lds + 98304 + w * 4096;
    if (first >= count) return;
    int ub, uh, uj; unit_of(first, ub, uh, uj);
#define SW_T0(j) ((j) >= 2 ? (j) - 2 : 0)
#define SW_DMA(b_, h_, j_, bo) do { const char* _ks = (const char*)(projr + (size_t)(b_) * SEQ * INW + SK0 + (h_) * 64 + w * 8); \
        const char* _vs = (const char*)(projr + ((size_t)(b_) * SEQ + (w & 3) * 16) * INW + SV0 + (h_) * 64 + (w >> 2) * 32); \
        const unsigned _ko = (unsigned)lane * (INW * 2), _vo = (unsigned)(lane >> 2) * (INW * 2) + (unsigned)(lane & 3) * 16; \
        for (int _t = SW_T0(j_); _t <= (j_); ++_t) { const int _sl = _t - SW_T0(j_); \
            __builtin_amdgcn_global_load_lds((const unsigned*)(_ks + (size_t)_t * (64 * INW * 2) + _ko), (ALAS unsigned*)(lds + (bo) + _sl * 8192 + w * 1024), 16, 0, 0); \
            __builtin_amdgcn_global_load_lds((const unsigned*)(_vs + (size_t)_t * (64 * INW * 2) + _vo), (ALAS unsigned*)(lds + (bo) + 24576 + _sl * 8192 + w * 1024), 16, 0, 0); } } while (0)
#define SW_QLD(Q, b_, h_, j_) do { const bf16_t* _qp = projr + ((size_t)(b_) * SEQ + (j_) * 64 + qsub * 32 + (lane & 31)) * INW + SQ0 + ((h_) * 4 + g) * 64 + 8 * (lane >> 5); \
        _Pragma("unroll") for (int d0 = 0; d0 < 4; ++d0) Q[d0] = *(const bf16x8*)(_qp + 16 * d0); } while (0)
    bf16x8 qf[4], qn[4];
    SW_QLD(qf, ub, uh, uj);
    SW_DMA(ub, uh, uj, 0);
    int bo = 0;
#pragma unroll 1
    for (int L = first; L < count; L += stride) {
        const bool has_next = L + stride < count;
        int nb = 0, nh = 0, nj = 0, nnt = 0;
        asm volatile("" : "+v"(lane));
        if (has_next) { unit_of(L + stride, nb, nh, nj); nnt = nj - SW_T0(nj) + 1; SW_QLD(qn, nb, nh, nj); SW_DMA(nb, nh, nj, 49152 - bo); }
        if (nnt == 3) asm volatile("s_waitcnt vmcnt(6)" ::: "memory"); else if (nnt == 2) asm volatile("s_waitcnt vmcnt(4)" ::: "memory"); else if (nnt == 1) asm volatile("s_waitcnt vmcnt(2)" ::: "memory"); else asm volatile("s_waitcnt vmcnt(0)" ::: "memory");
        __builtin_amdgcn_s_barrier(); asm volatile("" ::: "memory");
        const int r32 = lane & 31, hi = lane >> 5;
        const int q0 = uj * 64 + qsub * 32, t0 = SW_T0(uj);
        float m = sinks[uh * 4 + g] * 1.4426950408889634f, l = hi == 0 ? 1.0f : 0.f;
        f32x16 o[2]; o[0] = f32x16{}; o[1] = f32x16{};
        const int kfrag = hi * 1024 + r32 * 16;
        const int vfrag = 24576 + ((lane >> 4) & 1) * 32 + (lane & 3) * 8 + (4 * hi + ((lane & 15) >> 2)) * 64;
#pragma unroll 1
        for (int t = t0; t <= uj; ++t) {
            const int kv0 = t * 64, sl = t - t0;
            if ((kv0 > q0 + 31) || (q0 - (kv0 + 63) >= 128)) continue;
            const ALAS unsigned char* kb = lds + bo + sl * 8192 + kfrag;
            f32x16 p0 = f32x16{}, p1 = f32x16{};
#pragma unroll
            for (int d0 = 0; d0 < 4; ++d0) {
                const bf16x8 k0 = *(const ALAS bf16x8*)(kb + d0 * 2048), k1 = *(const ALAS bf16x8*)(kb + d0 * 2048 + 512);
                p0 = __builtin_amdgcn_mfma_f32_32x32x16_bf16(k0, qf[d0], p0, 0, 0, 0);
                p1 = __builtin_amdgcn_mfma_f32_32x32x16_bf16(k1, qf[d0], p1, 0, 0, 0);
            }
            if ((kv0 + 63 > q0) || (q0 + 31 - kv0 >= 128)) {
                const int qr = q0 + r32 - kv0 - 4 * hi;
#pragma unroll
                for (int r = 0; r < 16; ++r) {
                    if (CROWC(r) > qr || qr - CROWC(r) >= 128) p0[r] = -INFINITY;
                    if (CROWC(r) + 32 > qr || qr - CROWC(r) - 32 >= 128) p1[r] = -INFINITY;
                }
            }
            float mx = fmaxf(p0[0], p1[0]);
#pragma unroll
            for (int r = 1; r < 16; ++r) mx = fmaxf(mx, fmaxf(p0[r], p1[r]));
            mx = fmaxf(mx, __shfl_xor(mx, 32));
            if (__any(mx > m + THR)) {
                const float mn = fmaxf(m, mx), alpha = __builtin_amdgcn_exp2f(m - mn);
                m = mn; l *= alpha;
                scr[r32] = alpha;
#pragma unroll
                for (int r = 0; r < 16; ++r) { const float a = scr[4 * hi + CROWC(r)]; o[0][r] *= a; o[1][r] *= a; }
            }
            float ls = 0.f;
#pragma unroll
            for (int r = 0; r < 16; ++r) { p0[r] = __builtin_amdgcn_exp2f(p0[r] - m); p1[r] = __builtin_amdgcn_exp2f(p1[r] - m); ls += p0[r] + p1[r]; }
            l += ls;
            u32x4 pw[4];
#pragma unroll
            for (int s = 0; s < 2; ++s) {
                pw[s]     = (u32x4){cvtpk(p0[8 * s], p0[8 * s + 1]), cvtpk(p0[8 * s + 2], p0[8 * s + 3]), cvtpk(p0[8 * s + 4], p0[8 * s + 5]), cvtpk(p0[8 * s + 6], p0[8 * s + 7])};
                pw[2 + s] = (u32x4){cvtpk(p1[8 * s], p1[8 * s + 1]), cvtpk(p1[8 * s + 2], p1[8 * s + 3]), cvtpk(p1[8 * s + 4], p1[8 * s + 5]), cvtpk(p1[8 * s + 6], p1[8 * s + 7])};
            }
            const ALAS unsigned char* vb = lds + bo + sl * 8192 + vfrag;
#pragma unroll
            for (int d = 0; d < 2; ++d)
#pragma unroll
                for (int ks = 0; ks < 4; ++ks) {
                    const s16x4 lo = vtr(vb + d * 4096 + ks * 1024), hi4 = vtr(vb + d * 4096 + ks * 1024 + 512);
                    const bf16x8 vf = (bf16x8){lo[0], lo[1], lo[2], lo[3], hi4[0], hi4[1], hi4[2], hi4[3]};
                    o[d] = __builtin_amdgcn_mfma_f32_32x32x16_bf16(__builtin_bit_cast(bf16x8, pw[ks]), vf, o[d], 0, 0, 0);
                }
        }
        l += __shfl_xor(l, 32);
        scr[32 + r32] = l;
#pragma unroll
        for (int r = 0; r < 16; ++r) { const float inv = 1.0f / scr[32 + 4 * hi + CROWC(r)];
#pragma unroll
            for (int d = 0; d < 2; ++d) *(ALAS bf16_t*)(stg + (4 * hi + CROWC(r)) * 128 + (d * 32 + r32) * 2) = f2bf(o[d][r] * inv); }
        bf16_t* ob = ocat + ((size_t)ub * SEQ + q0) * DM + 512 + (uh * 4 + g) * 64;
#pragma unroll
        for (int i = 0; i < 4; ++i) { const int idx = i * 64 + lane, row = idx >> 3, ch = idx & 7;
            *(u32x4*)(ob + (size_t)row * DM + ch * 8) = *(const ALAS u32x4*)(stg + row * 128 + ch * 16); }
        asm volatile("s_waitcnt lgkmcnt(0)" ::: "memory"); __builtin_amdgcn_s_barrier(); asm volatile("" ::: "memory");
        ub = nb; uh = nh; uj = nj; bo = 49152 - bo;
#pragma unroll
        for (int d0 = 0; d0 < 4; ++d0) qf[d0] = qn[d0];
    }
#undef SW_T0
#undef SW_DMA
#undef SW_QLD
}
}

#define LAS __attribute__((address_space(3)))
#define GAS __attribute__((address_space(1)))
constexpr int NWAVES = 8;
constexpr int RING_BYTES = 131072;
constexpr int LX_BAR = RING_BYTES;
constexpr int LX_PST = RING_BYTES + 64;
constexpr int MOE_MAXU = 6;
constexpr int LX_TOK = RING_BYTES + 1024;
constexpr int LX_RST = LX_TOK + MOE_MAXU * 1024;
constexpr int LDS_BYTES = 147456;
static_assert(LX_RST + MOE_MAXU * 1024 <= LDS_BYTES, "LDS map");

constexpr size_t WS_WIN  = WS_END;
constexpr size_t WS_WOUT = WS_WIN + (size_t)(2304 + 2048) * 1024 * 2;
constexpr size_t WS_WQ   = WS_WOUT + (size_t)1024 * 1024 * 2;
constexpr size_t WS_WOC  = WS_WQ + (size_t)1024 * 1024 * 2;
constexpr size_t WS_WGU  = WS_WOC + (size_t)1024 * 1024 * 2;
constexpr size_t WS_WD   = WS_WGU + (size_t)32 * 1024 * 1024 * 2;
constexpr size_t WS_SSP1 = WS_WD + (size_t)32 * 1024 * 512 * 2;
constexpr size_t WS_SSP2 = WS_SSP1 + (size_t)NTOK * 16 * 4;
constexpr size_t WS_WR   = WS_SSP2 + (size_t)NTOK * 16 * 4;
constexpr int KVP = 2112;
constexpr size_t WS_KVC2 = WS_WR + (size_t)2 * 48 * 1024 * 2;
constexpr size_t WS_END2 = WS_KVC2 + (size_t)NMEM * KVP * 2;
static_assert(WS_END2 <= (size_t)512 * 1024 * 1024, "workspace too big");
constexpr int OCP = 4608;
constexpr int CW_BAR = 16;

#define XB_TMO      128
#define XB_XCNT(j)  (256  + 64 * (j))
#define XB_XSUB(j)  (1280 + 64 * (j))
#define XB_XGEN(j)  (2304 + 64 * (j))
#define XB_TOP      3328
#define XB_TOPGEN   3392
#define XCD_BAR_WORDS 3456
#define XB_LSUB(j)  (3456 + 64 * (j))
#define XB_LGEN(j)  (4480 + 64 * (j))
#define XB_SPIN_CAP (1u << 18)
__device__ __forceinline__ unsigned xb_ld(unsigned* p)              { return __hip_atomic_load(p, __ATOMIC_RELAXED, __HIP_MEMORY_SCOPE_AGENT); }
__device__ __forceinline__ unsigned xb_add(unsigned* p, unsigned v) { return __hip_atomic_fetch_add(p, v, __ATOMIC_RELAXED, __HIP_MEMORY_SCOPE_AGENT); }
__device__ __forceinline__ unsigned xb_xcc_id() { return (unsigned)__builtin_amdgcn_s_getreg((3 << 11) | 20) & 0xFu; }
#define XB_SPIN(cond, bar) do { unsigned _sp = 0; while (cond) { __builtin_amdgcn_s_sleep(1); \
    if ((++_sp & 255u) == 0u) { if (xb_ld(&(bar)[XB_TMO])) break; if (_sp > XB_SPIN_CAP) { atomicAdd(&(bar)[XB_TMO], 1u); break; } } } } while (0)
struct XcdBarrier { unsigned* bar; unsigned x; volatile LAS unsigned* st; };
__device__ __forceinline__ XcdBarrier xcd_barrier_post(unsigned* bar, volatile LAS unsigned* st) {
    XcdBarrier b; b.bar = bar; b.x = xb_xcc_id(); b.st = st;
    if (threadIdx.x == 0) st[2] = xb_add(&bar[XB_XCNT(b.x)], 1u);
    return b;
}
__device__ __forceinline__ void xcd_barrier_complete(unsigned* bar, unsigned x, unsigned& nloc, unsigned& nx) {
    const unsigned G = gridDim.x * gridDim.y * gridDim.z;
    unsigned sum, cnt, mine, sp = 0u;
    for (;;) {
        sum = 0u; cnt = 0u; mine = 0u;
#pragma unroll
        for (unsigned j = 0; j < 16; ++j) { const unsigned c = xb_ld(&bar[XB_XCNT(j)]); sum += c; cnt += (c > 0u) ? 1u : 0u; mine = (j == x) ? c : mine; }
        if (sum == G) break;
        __builtin_amdgcn_s_sleep(1);
        if ((++sp & 255u) == 0u) { if (xb_ld(&bar[XB_TMO])) break; if (sp > XB_SPIN_CAP) { atomicAdd(&bar[XB_TMO], 1u); break; } }
    }
    nloc = mine > 0u ? mine : 1u; nx = cnt > 0u ? cnt : 1u;
}
__device__ __forceinline__ void xcd_barrier(const XcdBarrier& b) {
    asm volatile("s_waitcnt vmcnt(0)" ::: "memory");
    __syncthreads();
    if (threadIdx.x == 0) {
        unsigned* bar = b.bar;
        __builtin_amdgcn_s_waitcnt(0);
        unsigned nloc = b.st[0], nx = b.st[1];
        if (nloc == 0u) { xcd_barrier_complete(bar, b.x, nloc, nx); b.st[0] = nloc; b.st[1] = nx; }
        const unsigned old = xb_add(&bar[XB_XSUB(b.x)], 1u);
        const unsigned gen = old / nloc;
        if (old + 1u == (gen + 1u) * nloc) {
            __builtin_amdgcn_fence(__ATOMIC_RELEASE, "agent");
            asm volatile("s_waitcnt vmcnt(0)" ::: "memory");
            const unsigned og = xb_add(&bar[XB_TOP], 1u);
            const unsigned tg = og / nx;
            if (og + 1u == (tg + 1u) * nx) xb_add(&bar[XB_TOPGEN], 1u);
            else XB_SPIN(xb_ld(&bar[XB_TOPGEN]) == tg, bar);
            __builtin_amdgcn_fence(__ATOMIC_ACQUIRE, "agent");
            xb_add(&bar[XB_XGEN(b.x)], 1u);
            asm volatile("s_waitcnt vmcnt(0)" ::: "memory");
        } else {
            XB_SPIN(xb_ld(&bar[XB_XGEN(b.x)]) == gen, bar);
            __builtin_amdgcn_fence(__ATOMIC_ACQUIRE, "agent");
            asm volatile("s_waitcnt vmcnt(0)" ::: "memory");
        }
    }
    __syncthreads();
}

__device__ __forceinline__ void xcd_local_barrier(const XcdBarrier& b, bool xl) {
    asm volatile("s_waitcnt vmcnt(0)" ::: "memory");
    __syncthreads();
    if (threadIdx.x == 0) {
        unsigned* bar = b.bar;
        __builtin_amdgcn_s_waitcnt(0);
        const unsigned slot = xl ? b.x : 15u, n = xl ? (unsigned)b.st[0] : gridDim.x;
        if (!xl) { __builtin_amdgcn_fence(__ATOMIC_RELEASE, "agent"); asm volatile("s_waitcnt vmcnt(0)" ::: "memory"); }
        const unsigned old = xb_add(&bar[XB_LSUB(slot)], 1u);
        const unsigned gen = old / n;
        if (old + 1u == (gen + 1u) * n) xb_add(&bar[XB_LGEN(slot)], 1u);
        else XB_SPIN(xb_ld(&bar[XB_LGEN(slot)]) == gen, bar);
        __builtin_amdgcn_fence(__ATOMIC_ACQUIRE, "agent");
        asm volatile("s_waitcnt vmcnt(0)" ::: "memory");
    }
    __syncthreads();
}

struct MkArgs {
    const float* in[26];
    float* out; unsigned char* ws;
    int ph_lo, ph_hi, li, pad;
};

__device__ __forceinline__ unsigned pk2rn(float lo, float hi) { return (unsigned)f2bf(lo) | ((unsigned)f2bf(hi) << 16); }
__device__ __forceinline__ int in_rowmap(int n0);
struct P0Item { const float* W; bf16_t* WT; const float* gain; int K, N, dst_row0, k0, n0, rowmap; float q8; };
__device__ __forceinline__ void p0_item_load(const P0Item& it, pg8::f32x4 (&v)[16], int lane) {
    const float* src = it.W + (size_t)(it.k0 + 16 * (lane >> 4)) * it.N + it.n0 + (lane & 15) * 4;
#pragma unroll
    for (int i = 0; i < 16; ++i) v[i] = __builtin_nontemporal_load((const pg8::f32x4*)(src + (size_t)i * it.N));
}
__device__ __forceinline__ void p0_item_store(const P0Item& it, pg8::f32x4 (&v)[16], int lane) {
    const int n4 = (lane & 15) * 4, kq = lane >> 4;
    if (it.gain) {
#pragma unroll
        for (int i = 0; i < 16; ++i) v[i] = v[i] * it.gain[it.k0 + 16 * kq + i];
    }
    const int n = it.n0 + n4;
    int drow;
    if (it.rowmap == 0) drow = it.dst_row0 + n; else if (it.rowmap == 1) drow = in_rowmap(n & ~31) + (n & 31); else drow = it.dst_row0 + 256 * (n >> 7) + (n & 127);
    if (it.q8 != 0.f) {
#pragma unroll
        for (int j = 0; j < 4; ++j) {
            int w[4];
#pragma unroll
            for (int q = 0; q < 4; ++q) { int t = 0; t = __builtin_amdgcn_cvt_pk_fp8_f32(__builtin_amdgcn_fmed3f(v[4 * q][j] * it.q8, -448.0f, 448.0f), __builtin_amdgcn_fmed3f(v[4 * q + 1][j] * it.q8, -448.0f, 448.0f), t, false); t = __builtin_amdgcn_cvt_pk_fp8_f32(__builtin_amdgcn_fmed3f(v[4 * q + 2][j] * it.q8, -448.0f, 448.0f), __builtin_amdgcn_fmed3f(v[4 * q + 3][j] * it.q8, -448.0f, 448.0f), t, true); w[q] = t; }
            pg8::u32x4v o; o.x = (unsigned)w[0]; o.y = (unsigned)w[1]; o.z = (unsigned)w[2]; o.w = (unsigned)w[3];
            __builtin_nontemporal_store(o, (pg8::u32x4v*)((unsigned char*)it.WT + (size_t)(drow + j) * it.K + it.k0 + 16 * kq));
        }
        return;
    }
#pragma unroll
    for (int j = 0; j < 4; ++j) {
        pg8::u32x4v o0, o1;
        o0.x = pk2rn(v[0][j], v[1][j]); o0.y = pk2rn(v[2][j], v[3][j]); o0.z = pk2rn(v[4][j], v[5][j]); o0.w = pk2rn(v[6][j], v[7][j]);
        o1.x = pk2rn(v[8][j], v[9][j]); o1.y = pk2rn(v[10][j], v[11][j]); o1.z = pk2rn(v[12][j], v[13][j]); o1.w = pk2rn(v[14][j], v[15][j]);
        bf16_t* dst = it.WT + (size_t)(drow + j) * it.K + it.k0 + 16 * kq;
        *(pg8::u32x4v*)dst = o0; *(pg8::u32x4v*)(dst + 8) = o1;
    }
}
__device__ __forceinline__ int in_rowmap(int n0) {
    if (n0 < 1024 || (n0 >= 1536 && n0 < 2048)) { const int base = (n0 < 512) ? 0 : (n0 < 1024 ? 512 : 1536), cc = n0 - base; return base + 256 * (cc >> 8) + ((cc >> 5) & 1) * 128 + ((cc >> 6) & 3) * 32; }
    if (n0 < 1536) return n0;
    if (n0 < 2176) { const int cc = n0 - 2048; return 2048 + ((cc >> 5) & 1) * 128 + (cc >> 6) * 32; }
    const int e = n0 - 2176; return 2048 + (e >> 6) * 128 + 64 + (e & 63);
}

struct MoeIt { const float* src; unsigned char* dst; const float* gp; int N, K; float q8; bool gsel; };
__device__ __forceinline__ void moe_decode(MoeIt& m, int r, const float* w_gate, const float* w_up, const float* w_down, const float* ln_moe_w, unsigned char* Wgu8, unsigned char* Wd8, int lane) {
    constexpr int IE = 16 * 8 * 32;
    const int n4 = (lane & 15) * 4, kq = lane >> 4;
    const float* W; unsigned char* db; int k0, n, drow;
    if (r < 2 * IE) { const int up = r >= IE ? 1 : 0; if (up) r -= IE; const int e = r >> 7, q = r & 127, kb = q >> 3, nb = q & 7;
        W = (up ? w_up : w_gate) + (size_t)e * 1024 * 512; m.N = 512; m.K = 1024; k0 = kb * 64; n = nb * 64 + n4; drow = e * 1024 + up * 128 + 256 * (n >> 7) + (n & 127); db = Wgu8; m.q8 = 64.0f; m.gsel = true; }
    else { r -= 2 * IE; const int e = r >> 7, q = r & 127, kb = q >> 4, nb = q & 15;
        W = w_down + (size_t)e * 512 * 1024; m.N = 1024; m.K = 512; k0 = kb * 64; n = nb * 64 + n4; drow = e * 1024 + n; db = Wd8; m.q8 = 32.0f; m.gsel = false; }
    m.src = W + (size_t)(k0 + 16 * kq) * m.N + n;
    m.dst = db + (size_t)drow * m.K + k0 + 16 * kq;
    m.gp = ln_moe_w + k0 + 16 * kq;
}
__device__ __forceinline__ void moe_load(const MoeIt& m, pg8::f32x4 (&g)[4], pg8::f32x4 (&v)[16]) {
#pragma unroll
    for (int c = 0; c < 4; ++c) g[c] = *(const pg8::f32x4*)(m.gp + 4 * c);
#pragma unroll
    for (int i = 0; i < 16; ++i) v[i] = __builtin_nontemporal_load((const pg8::f32x4*)(m.src + (size_t)i * m.N));
}
__device__ __forceinline__ void moe_store(const MoeIt& m, const pg8::f32x4 (&g)[4], const pg8::f32x4 (&v)[16]) {
    float gq[16];
#pragma unroll
    for (int i = 0; i < 16; ++i) gq[i] = m.gsel ? g[i >> 2][i & 3] * m.q8 : m.q8;
#pragma unroll
    for (int j = 0; j < 4; ++j) {
        int w[4];
#pragma unroll
        for (int q = 0; q < 4; ++q) { int t = 0;
            t = __builtin_amdgcn_cvt_pk_fp8_f32(__builtin_amdgcn_fmed3f(v[4 * q][j] * gq[4 * q], -448.0f, 448.0f), __builtin_amdgcn_fmed3f(v[4 * q + 1][j] * gq[4 * q + 1], -448.0f, 448.0f), t, false);
            t = __builtin_amdgcn_cvt_pk_fp8_f32(__builtin_amdgcn_fmed3f(v[4 * q + 2][j] * gq[4 * q + 2], -448.0f, 448.0f), __builtin_amdgcn_fmed3f(v[4 * q + 3][j] * gq[4 * q + 3], -448.0f, 448.0f), t, true); w[q] = t; }
        pg8::u32x4v o; o.x = (unsigned)w[0]; o.y = (unsigned)w[1]; o.z = (unsigned)w[2]; o.w = (unsigned)w[3];
        __builtin_nontemporal_store(o, (pg8::u32x4v*)(m.dst + (size_t)j * m.K));
    }
}

__global__ void __launch_bounds__(NWAVES * 64, 2) mk_fwd(MkArgs args) {
    extern __shared__ __attribute__((aligned(16))) unsigned char lds_raw[];
    LAS unsigned char* lds = (LAS unsigned char*)lds_raw;
    const int tid = threadIdx.x, wave = __builtin_amdgcn_readfirstlane(tid >> 6);
    const int G = gridDim.x; int bx = blockIdx.x;
    int gw = bx * NWAVES + wave; const int NGW = G * NWAVES;
    bool xl = false;
    unsigned char* ws = args.ws;
    unsigned* ctl = (unsigned*)(ws + WS_CTL);
#define KGP(T, v) ((T*)(__attribute__((address_space(1))) T*)(v))
#define KPTRS \
        const __attribute__((address_space(4))) unsigned long long* kp_ = (const __attribute__((address_space(4))) unsigned long long*)__builtin_amdgcn_kernarg_segment_ptr(); \
        asm volatile("" : "+s"(kp_)); \
        unsigned char* ws = KGP(unsigned char, kp_[27]); unsigned* ctl = (unsigned*)(ws + WS_CTL); float* const out_ = KGP(float, kp_[26]); \
        const float* x = KGP(const float, kp_[0]); const float* mem = KGP(const float, kp_[1]); const int* positions = (const int*)KGP(const float, kp_[2]); \
        const float* ln_mix_w = KGP(const float, kp_[3]); const float* w_in = KGP(const float, kp_[4]); \
        const float* w_out = KGP(const float, kp_[11]); const float* ln_cross_w = KGP(const float, kp_[12]); const float* ln_mem_w = KGP(const float, kp_[13]); const float* wq_cross = KGP(const float, kp_[14]); \
        const float* wkv_cross = KGP(const float, kp_[15]); const float* wo_cross = KGP(const float, kp_[16]); const float* ln_moe_w = KGP(const float, kp_[17]); \
        const float* w_group = KGP(const float, kp_[18]); const float* b_group = KGP(const float, kp_[19]); const float* w_expert = KGP(const float, kp_[20]); const float* b_expert = KGP(const float, kp_[21]); \
        const float* w_gate = KGP(const float, kp_[22]); const float* w_up = KGP(const float, kp_[23]); const float* w_down = KGP(const float, kp_[24]); const float* ln_final_w = KGP(const float, kp_[25]); \
        float* rstd0 = (float*)(ws + WS_RSTD0); float* rstdm = (float*)(ws + WS_RSTDM); float* rstd2 = (float*)(ws + WS_RSTD2); \
        float* ropet = (float*)(ws + WS_ROPE); \
        int* tok_e = (int*)(ws + WS_TOKE); int* tok_i = (int*)(ws + WS_TOKI); float* tok_g = (float*)(ws + WS_TOKG); int* explist = (int*)(ws + WS_EXPL); \
        bf16_t* kvc = (bf16_t*)(ws + WS_KVC2); \
        bf16_t* xb = (bf16_t*)(ws + WS_S0); bf16_t* mb = xb + (size_t)NTOK * DM; bf16_t* qc = (bf16_t*)(ws + WS_S0); bf16_t* hdn = (bf16_t*)(ws + WS_S0); \
        bf16_t* projr = (bf16_t*)(ws + WS_S1); bf16_t* oc = (bf16_t*)(ws + WS_S1); bf16_t* y = (bf16_t*)(ws + WS_S1); \
        bf16_t* ocat = (bf16_t*)(ws + WS_S2); bf16_t* h2b = (bf16_t*)(ws + WS_S2); \
        bf16_t* h1b = (bf16_t*)(ws + WS_S3); \
        bf16_t* WinT = (bf16_t*)(ws + WS_WIN); bf16_t* WoutT = (bf16_t*)(ws + WS_WOUT); bf16_t* WqT = (bf16_t*)(ws + WS_WQ); bf16_t* WocT = (bf16_t*)(ws + WS_WOC); \
        unsigned char* Wgu8 = ws + WS_WGU; unsigned char* Wd8 = ws + WS_WD; \
        unsigned char* h2q = ws + WS_WGU + (size_t)32 * 1024 * 1024; \
        unsigned char* hdn8 = ws + WS_S0; \
        unsigned char* y8 = ws + WS_S1; \
        unsigned char* Wq8 = ws + WS_WQ; unsigned char* Woc8 = ws + WS_WOC; \
        unsigned char* oc8 = ws + WS_S1;     \
        unsigned char* h1q = ws + WS_S1 + 2048;     \
        float* ssp1 = (float*)(ws + WS_SSP1); float* ssp2 = (float*)(ws + WS_SSP2); \
        bf16_t* WrT = (bf16_t*)(ws + WS_WR); \
        int* counts = (int*)(ctl + CW_COUNTS);

    for (int u = tid; u < (LDS_BYTES - RING_BYTES) / 4; u += NWAVES * 64) ((LAS unsigned*)(lds + RING_BYTES))[u] = 0u;
    __syncthreads();
    XcdBarrier bar = xcd_barrier_post(ctl + CW_BAR + args.li * XCD_BAR_WORDS, (volatile LAS unsigned*)(lds + LX_BAR));
    const int lo = args.ph_lo, hi = args.ph_hi;
#define IN(k) (lo <= (k) && (k) < hi)
#define SEAM(k) do { if (IN(k) && IN((k) + 1)) xcd_barrier(bar); } while (0)
#define LSEAM(k) do { if (IN(k) && IN((k) + 1)) xcd_local_barrier(bar, xl); } while (0)

    constexpr int I0 = 16 * 36, I1 = 16 * 32, I2 = 16 * 16, IE = 16 * 8 * 32, ID = 8 * 16 * 32;
    constexpr int NMAIN = I0 + I1 + 3 * I2, NMOE = 2 * IE + ID;
#define P0_DECODE_MAIN(IT, idx) do { int r = (idx); \
            if (r < I0) { const int kb = r / 36, nb = r % 36; IT = P0Item{w_in, WinT, ln_mix_w, 1024, 2304, 0, kb * 64, nb * 64, 1, 0.f}; } \
            else if ((r -= I0) < I1) { const int kb = r / 32, nb = r % 32; IT = P0Item{wkv_cross, WinT, ln_mem_w, 1024, 2048, 2304, kb * 64, nb * 64, 0, 0.f}; } \
            else if ((r -= I1) < I2) { const int kb = r / 16, nb = r % 16; IT = P0Item{w_out, WoutT, nullptr, 1024, 1024, 0, kb * 64, nb * 64, 0, 0.f}; } \
            else if ((r -= I2) < I2) { const int kb = r / 16, nb = r % 16; IT = P0Item{wq_cross, (bf16_t*)Wq8, ln_cross_w, 1024, 1024, 0, kb * 64, nb * 64, 0, 64.0f}; } \
            else { r -= I2; const int kb = r / 16, nb = r % 16; IT = P0Item{wo_cross, (bf16_t*)Woc8, nullptr, 1024, 1024, 0, kb * 64, nb * 64, 0, 64.0f}; } } while (0)
#define P0_DECODE_MOE(IT, idx) do { int r = (idx); \
            if (r < 2 * IE) { const int up = r >= IE ? 1 : 0; if (up) r -= IE; const int e = r >> 7, q = r & 127, kb = q >> 3, nb = q & 7; \
                IT = P0Item{(up ? w_up : w_gate) + (size_t)e * 1024 * 512, (bf16_t*)Wgu8, ln_moe_w, 1024, 512, e * 1024 + up * 128, kb * 64, nb * 64, 2, 64.0f}; } \
            else { r -= 2 * IE; const int e = r >> 7, q = r & 127, kb = q >> 4, nb = q & 15; IT = P0Item{w_down + (size_t)e * 512 * 1024, (bf16_t*)Wd8, nullptr, 512, 1024, e * 1024, kb * 64, nb * 64, 0, 32.0f}; } } while (0)
#define P0_RUN(DEC, first, step, end) do { if ((first) < (end)) { \
            P0Item itc, itn; pg8::f32x4 vc[16], vn[16]; \
            DEC(itc, (first)); p0_item_load(itc, vc, lane); \
            for (int it = (first); it < (end); it += (step)) { \
                const bool has_next = it + (step) < (end); \
                if (has_next) { DEC(itn, it + (step)); p0_item_load(itn, vn, lane); } \
                p0_item_store(itc, vc, lane); \
                if (has_next) { itc = itn; _Pragma("unroll") for (int i = 0; i < 16; ++i) vc[i] = vn[i]; } \
            } } } while (0)
#define MOE_RUN(first, step, end) do { \
            const int cnt_ = (first) < (end) ? ((end) - (first) + (step) - 1) / (step) : 0, npair_ = cnt_ >> 1; \
            if (npair_ > 0) { \
                MoeIt ma, mb; pg8::f32x4 ga[4], gb[4], va[16], vb[16]; int r_ = (first); \
                moe_decode(ma, r_, w_gate, w_up, w_down, ln_moe_w, Wgu8, Wd8, lane); moe_load(ma, ga, va); __builtin_amdgcn_sched_barrier(0); \
                for (int p_ = 0; p_ < npair_ - 1; ++p_) { \
                    moe_decode(mb, r_ + (step), w_gate, w_up, w_down, ln_moe_w, Wgu8, Wd8, lane); moe_load(mb, gb, vb); __builtin_amdgcn_sched_barrier(0); \
                    moe_store(ma, ga, va); \
                    r_ += 2 * (step); \
                    moe_decode(ma, r_, w_gate, w_up, w_down, ln_moe_w, Wgu8, Wd8, lane); moe_load(ma, ga, va); __builtin_amdgcn_sched_barrier(0); \
                    moe_store(mb, gb, vb); \
                } \
                moe_decode(mb, r_ + (step), w_gate, w_up, w_down, ln_moe_w, Wgu8, Wd8, lane); moe_load(mb, gb, vb); __builtin_amdgcn_sched_barrier(0); \
                moe_store(ma, ga, va); moe_store(mb, gb, vb); \
            } \
            P0_RUN(P0_DECODE_MOE, (first) + 2 * npair_ * (step), (step), (end)); \
        } while (0)
    constexpr int P1_IPW = 0;
    const int p1rem = 1216 % G, p1idle_w = p1rem ? (G - p1rem) * NWAVES : 0;
    const int NA = p1idle_w * P1_IPW < NMOE ? p1idle_w * P1_IPW : NMOE;
    if (IN(0)) { KPTRS
        const int lane = fresh_tid() & 63;
        P0_RUN(P0_DECODE_MAIN, gw, NGW, NMAIN);
        for (int idx = bx * 512 + tid; idx < 48 * 1024; idx += G * 512) {
            const int row = idx >> 10, k = idx & 1023, rr = row & 15, fq4 = rr >> 2, reg = rr & 3;
            const float wv = (row < 16 ? w_group[k * 4 + (row & 3)] : w_expert[k * 32 + 8 * fq4 + (row >= 32 ? 4 : 0) + reg]) * ln_moe_w[k];
            const bf16_t hb = f2bf(wv);
            WrT[idx] = hb; WrT[48 * 1024 + idx] = f2bf(wv - bf2f(hb));
        }
        {
            pg8::f32x4 vc[2][4], vn[2][4];
#define P0_XLOAD(V, row2) do { _Pragma("unroll") for (int h2 = 0; h2 < 2; ++h2) { const int row = (row2) * 2 + h2; const float* src = row < NTOK ? x + (size_t)row * DM : mem + (size_t)(row - NTOK) * DM; \
                _Pragma("unroll") for (int i = 0; i < 4; ++i) V[h2][i] = __builtin_nontemporal_load(&((const pg8::f32x4*)src)[lane + 64 * i]); } } while (0)
            if (gw < (NTOK + NMEM) / 2) P0_XLOAD(vc, gw);
            for (int row2 = gw; row2 < (NTOK + NMEM) / 2; row2 += NGW) {
                const bool has_next = row2 + NGW < (NTOK + NMEM) / 2;
                if (has_next) P0_XLOAD(vn, row2 + NGW);
#pragma unroll
                for (int h2 = 0; h2 < 2; ++h2) { const int row = row2 * 2 + h2; float ss = 0.f;
#pragma unroll
                    for (int i = 0; i < 4; ++i) { const pg8::f32x4 t = vc[h2][i]; ss += (t[0] * t[0] + t[1] * t[1]) + (t[2] * t[2] + t[3] * t[3]);
                        uint2 o; o.x = pk2rn(t[0], t[1]); o.y = pk2rn(t[2], t[3]); ((uint2*)(xb + (size_t)row * DM))[lane + 64 * i] = o; }
                    ss = wave_sum(ss);
                    if (lane == 0) { const float rs = rsqrtf(ss * (1.0f / DM) + EPS); if (row < NTOK) rstd0[row] = rs; else rstdm[row - NTOK] = rs; } }
                if (has_next) {
#pragma unroll
                    for (int h2 = 0; h2 < 2; ++h2)
#pragma unroll
                        for (int i = 0; i < 4; ++i) vc[h2][i] = vn[h2][i]; }
            }
#undef P0_XLOAD
        }
        for (int idx = bx * 512 + tid; idx < NTOK * 32; idx += G * 512) {
            const int row = idx >> 5, i = idx & 31;
            const double inv_freq = exp(-9.210340371976184 * (double)(2 * i) / 64.0);
            const double rev = (double)positions[row] * inv_freq * 0.15915494309189535;
            const float fr = (float)(rev - floor(rev));
            ((unsigned*)ropet)[idx] = (unsigned)f2bf(__builtin_amdgcn_cosf(fr)) | ((unsigned)f2bf(__builtin_amdgcn_sinf(fr)) << 16);
        }
    }
    SEAM(0);
    if (lo == 0 && hi == 11) {
        volatile LAS unsigned* st = (volatile LAS unsigned*)(lds + LX_BAR);
        if (tid == 0) { bool ok = (G % 8 == 0) && bar.x < 8u;
            for (unsigned j = 0; j < 16; ++j) { const unsigned c = xb_ld(&bar.bar[XB_XCNT(j)]); ok = ok && (c == (j < 8u ? (unsigned)G / 8u : 0u)); }
            st[3] = ok ? 1u : 0u; }
        __syncthreads();
        xl = __builtin_amdgcn_readfirstlane(st[3]) != 0u;
        if (xl) { bx = (int)(__builtin_amdgcn_readfirstlane(st[2]) * 8u + bar.x); gw = bx * NWAVES + wave; }
    }
    if (IN(1)) { KPTRS
        pg8::Gemm g{xb, WinT, NTOK + NMEM, 2304 + 2048, 1024}; pg8::InProjOrder S{G, bx};
        LAS float* rst = (LAS float*)(lds + LX_RST);
        { pg8::Unit u; float tv[MOE_MAXU]; bool ok[MOE_MAXU];
#pragma unroll
          for (int i = 0; i < MOE_MAXU; ++i) { ok[i] = S.next(i, u) && tid < 256; tv[i] = ok[i] ? rstd0[u.pm * 256 + tid] : 0.f; }
#pragma unroll
          for (int i = 0; i < MOE_MAXU; ++i) if (ok[i]) rst[i * 256 + tid] = tv[i];
          __syncthreads(); }
        pg8::EpiInProj E{projr, kvc, rst, (const unsigned*)ropet};
        pg8::gemm_phase<pg8::EpiInProj, pg8::InProjOrder, true, true, false>(lds, g, S, E);
        if (p1rem && bx >= p1rem) { KPTRS const int lane = fresh_tid() & 63; const int first = (bx - p1rem) * NWAVES + wave; P0_RUN(P0_DECODE_MOE, first, p1idle_w, NA); }
    }
    LSEAM(1);
    if (IN(2)) { KPTRS
        const float* lq1 = KGP(const float, kp_[5]); const float* lk1 = KGP(const float, kp_[6]); const float* lq2 = KGP(const float, kp_[7]); const float* lk2 = KGP(const float, kp_[8]);
        const float* subln_w = KGP(const float, kp_[9]); const float* sinks = KGP(const float, kp_[10]);
        const int lane = fresh_tid() & 63;
        const float a1 = wave_sum(lq1[lane] * lk1[lane]), a2 = wave_sum(lq2[lane] * lk2[lane]);
        const float lam = __uint_as_float(__builtin_amdgcn_readfirstlane(__float_as_uint(expf(a1) - expf(a2) + LAMBDA_INIT)));
        const int vcu = (G % 8 == 0) ? (bx % 8) * (G / 8) + bx / 8 : bx;
        const int nb4 = 1;
        int L = vcu, nun = 0;
        for (; L < 1024 && nun < nb4; L += G, ++nun) {
            const int v = L & 255, bh = v >> 3, s = v & 7, i = ((L >> 8) + bh) & 3, qb = (i == 0) ? s : (i == 1) ? 15 - s : (i == 2) ? 16 + s : 31 - s;
            att::diff_unit(lds, projr, ocat, bh >> 2, bh & 3, qb, lam, subln_w);
        }
        { const int lane2 = fresh_tid() & 63; { KPTRS const int lane = lane2; MOE_RUN(NA + gw, NGW, NMOE); } }
        for (; L < 1024; L += G) {
            const int v = L & 255, bh = v >> 3, s = v & 7, i = ((L >> 8) + bh) & 3, qb = (i == 0) ? s : (i == 1) ? 15 - s : (i == 2) ? 16 + s : 31 - s;
            att::diff_unit(lds, projr, ocat, bh >> 2, bh & 3, qb, lam, subln_w);
        }
        __syncthreads();
        att::swa_phase(lds, projr, ocat, sinks, vcu, G, 1024, [](int L, int& b_, int& h_, int& j_) { const int u_ = (L & 31) + 32 * (L >> 8); b_ = (L & 255) >> 5; h_ = u_ >> 6; j_ = u_ & 63; });
    }
    LSEAM(2);
    if (IN(3)) { KPTRS
        pg8::Gemm g{ocat, WoutT, NTOK, 1024, 1024}; pg8::StaticOrder S; S.init(NTOK, 1024, G, bx);
        pg8::EpiRes E{xb, h1b, ssp1, h1q, 1.0f, OCP};
        pg8::gemm_phase<pg8::EpiRes, pg8::StaticOrder, true, true, false>(lds, g, S, E);
    }
    LSEAM(3);
    if (IN(4)) { KPTRS
        pg8::Gemm g{(const bf16_t*)h1q, (const bf16_t*)Wq8, NTOK, 1024, 512, OCP / 2}; pg8::StaticOrderUi S; S.init(NTOK, 1024, G, bx);
        LAS float* rst = (LAS float*)(lds + LX_RST);
        { pg8::Unit u;
#pragma unroll
          for (int i = 0; i < 2; ++i) if (S.next(i, u) && tid < 256) rst[i * 256 + tid] = pg8::rstd_from_ssp(ssp1, u.pm * 256 + tid) * (C2_CROSS / 64.0f);
          { pg8::Unit u2; if (S.next(2, u2)) for (int i = 2; i < MOE_MAXU && S.next(i, u2); ++i) if (tid < 256) rst[i * 256 + tid] = pg8::rstd_from_ssp(ssp1, u2.pm * 256 + tid) * (C2_CROSS / 64.0f); }
          __syncthreads(); }
        pg8::EpiScale E{qc, rst};
        pg8::gemm_phase<pg8::EpiScale, pg8::StaticOrderUi, true, true, false, true>(lds, g, S, E);
    }
    if (IN(4) && IN(5)) {
        asm volatile("s_waitcnt vmcnt(0)" ::: "memory"); __syncthreads();
        __builtin_amdgcn_fence(__ATOMIC_ACQUIRE, "agent"); asm volatile("s_waitcnt vmcnt(0)" ::: "memory"); __syncthreads();
    }
    if (IN(5)) { KPTRS
        pg8::StaticOrder S; S.init(NTOK, 1024, G, bx);
        att::cross_phase(lds, qc, kvc, oc8, OCP, S);
    }
    LSEAM(5);
    if (IN(6)) { KPTRS
        pg8::Gemm g{(const bf16_t*)oc8, (const bf16_t*)Woc8, NTOK, 1024, 512, OCP / 2}; pg8::StaticOrder S; S.init(NTOK, 1024, G, bx);
        pg8::EpiRes E{h1b, h2b, ssp2, h2q, 1.0f / 1024.0f, 1024};
        pg8::gemm_phase<pg8::EpiRes, pg8::StaticOrder, true, true, false, true>(lds, g, S, E);
    }
    LSEAM(6);
    if (IN(7)) { KPTRS
        LAS float* part = (LAS float*)lds; LAS int* lcnt = (LAS int*)(lds + 98304); LAS int* gbase = lcnt + 32;
        const int lane = fresh_tid() & 63;
        const int fq = lane >> 4;
        for (int blk0 = bx; blk0 < NTOK / 128; blk0 += G) {
            const int blk = (G % 8 == 0 && NTOK / 128 == G) ? (blk0 % 8) * (G / 8) + blk0 / 8 : blk0;
            if (tid < 32) lcnt[tid] = 0;
            pg8::bf16x8 wf[3][2][4];
            { const bf16_t* wh = WrT + (size_t)(lane & 15) * 1024 + 128 * wave + 8 * fq;
#pragma unroll
              for (int j = 0; j < 3; ++j)
#pragma unroll
                  for (int p = 0; p < 2; ++p)
#pragma unroll
                      for (int s = 0; s < 4; ++s) wf[j][p][s] = *(const pg8::bf16x8*)(wh + p * 49152 + j * 16384 + 32 * s); }
            int e0r[2], e1r[2], li0[2], li1[2]; float g0r[2], g1r[2], rsr[2]; bool actr[2];
#pragma unroll
            for (int r = 0; r < 2; ++r) {
#pragma unroll 1
                for (int gl = 0; gl < 4; ++gl) {
                    const int tok = blk * 128 + (4 * r + gl) * 16 + (lane & 15);
                    const bf16_t* ap = h2b + (size_t)tok * DM + 128 * wave + 8 * fq;
                    pg8::f32x4 acc[3];
#pragma unroll
                    for (int j = 0; j < 3; ++j) acc[j] = (pg8::f32x4){0.f, 0.f, 0.f, 0.f};
#pragma unroll
                    for (int s = 0; s < 4; ++s) { const pg8::bf16x8 a = *(const pg8::bf16x8*)(ap + 32 * s);
#pragma unroll
                        for (int j = 0; j < 3; ++j) { acc[j] = __builtin_amdgcn_mfma_f32_16x16x32_bf16(wf[j][0][s], a, acc[j], 0, 0, 0); acc[j] = __builtin_amdgcn_mfma_f32_16x16x32_bf16(wf[j][1][s], a, acc[j], 0, 0, 0); } }
#pragma unroll
                    for (int j = 0; j < 3; ++j)
#pragma unroll
                        for (int c = 0; c < 4; ++c) part[((wave * 4 + gl) * 12 + j * 4 + c) * 64 + lane] = acc[j][c];
                }
                __syncthreads();
                actr[r] = false; e0r[r] = 0; e1r[r] = 0; li0[r] = 0; li1[r] = 0; g0r[r] = 0.f; g1r[r] = 0.f; rsr[r] = 0.f;
                if (wave < 4) {
                    float v[12];
#pragma unroll
                    for (int q = 0; q < 12; ++q) v[q] = 0.f;
#pragma unroll 1
                    for (int ww = 0; ww < 8; ++ww) {
#pragma unroll
                        for (int q = 0; q < 12; ++q) v[q] += part[((ww * 4 + wave) * 12 + q) * 64 + lane]; }
                    const int tok = blk * 128 + (4 * r + wave) * 16 + (lane & 15);
                    const float rs = pg8::rstd_from_ssp(ssp2, tok);
                    float lg[4], el[8];
#pragma unroll
                    for (int j = 0; j < 4; ++j) { lg[j] = v[j] * rs + b_group[j]; el[j] = v[4 + j] * rs + b_expert[8 * fq + j]; el[4 + j] = v[8 + j] * rs + b_expert[8 * fq + 4 + j]; }
                    int gs = 0; float gm = lg[0];
#pragma unroll
                    for (int j = 1; j < 4; ++j) if (lg[j] > gm) { gm = lg[j]; gs = j; }
                    float gden = 0.f;
#pragma unroll
                    for (int j = 0; j < 4; ++j) gden += expf(lg[j] - gm);
                    const float gp = 1.0f / gden;
                    int i0 = 0; float v0 = el[0];
#pragma unroll
                    for (int j = 1; j < 8; ++j) if (el[j] > v0) { v0 = el[j]; i0 = j; }
                    int i1 = (i0 == 0) ? 1 : 0; float v1 = -INFINITY;
#pragma unroll
                    for (int j = 0; j < 8; ++j) if (j != i0 && el[j] > v1) { v1 = el[j]; i1 = j; }
                    const float w0 = 1.0f / (1.0f + expf(v1 - v0));
                    if (fq == gs) {
                        actr[r] = true; e0r[r] = gs * 8 + i0; e1r[r] = gs * 8 + i1; g0r[r] = gp * w0; g1r[r] = gp * (1.0f - w0); rsr[r] = rs;
                        li0[r] = __hip_atomic_fetch_add(lcnt + e0r[r], 1, __ATOMIC_RELAXED, __HIP_MEMORY_SCOPE_WORKGROUP);
                        li1[r] = __hip_atomic_fetch_add(lcnt + e1r[r], 1, __ATOMIC_RELAXED, __HIP_MEMORY_SCOPE_WORKGROUP);
                    }
                }
                __syncthreads();
            }
            if (tid < 32) gbase[tid] = atomicAdd(&counts[tid], lcnt[tid]);
            __syncthreads();
            if (wave < 4) {
#pragma unroll
                for (int r = 0; r < 2; ++r) if (actr[r]) {
                    const int tok = blk * 128 + (4 * r + wave) * 16 + (lane & 15);
                    const int e0 = e0r[r], e1 = e1r[r], x0 = gbase[e0] + li0[r], x1 = gbase[e1] + li1[r];
                    explist[(size_t)e0 * NTOK + x0] = tok; explist[(size_t)e1 * NTOK + x1] = tok;
                    tok_e[tok * 2] = e0; tok_e[tok * 2 + 1] = e1; tok_i[tok * 2] = x0; tok_i[tok * 2 + 1] = x1;
                    tok_g[tok * 2] = g0r[r]; tok_g[tok * 2 + 1] = g1r[r];
                    rstd2[tok] = rsr[r];
                }
            }
            __syncthreads();
        }
    }
    SEAM(7);
    if (IN(8) || IN(9)) { KPTRS
        LAS int* pst = (LAS int*)(lds + LX_PST);
        if (tid == 0) { int s = 0; for (int e = 0; e < 32; ++e) { pst[e] = s; s += (counts[e] + 255) >> 8; } pst[32] = s; }
        __syncthreads();
    }
    if (IN(8)) { KPTRS
        LAS int* pst = (LAS int*)(lds + LX_PST); LAS int* tokt = (LAS int*)(lds + LX_TOK); LAS float* rst = (LAS float*)(lds + LX_RST);
        pg8::MoeOrder S{G, bx, pst[32], pst, tokt};
        {
            pg8::Unit u; int tk[MOE_MAXU]; float tr[MOE_MAXU]; bool ok[MOE_MAXU];
#pragma unroll
            for (int i = 0; i < MOE_MAXU; ++i) { ok[i] = S.next(i, u) && tid < 256; tk[i] = 0;
                if (ok[i]) { const int e = u.pn >> 2, idx = (u.pm - pst[e]) * 256 + tid, cnt = counts[e]; tk[i] = explist[(size_t)e * NTOK + (idx < cnt ? idx : 0)]; } }
#pragma unroll
            for (int i = 0; i < MOE_MAXU; ++i) tr[i] = ok[i] ? rstd2[tk[i]] : 0.f;
#pragma unroll
            for (int i = 0; i < MOE_MAXU; ++i) if (ok[i]) { tokt[i * 256 + tid] = tk[i]; rst[i * 256 + tid] = tr[i]; }
            __syncthreads();
        }
        pg8::Gemm g{(const bf16_t*)h2q, (const bf16_t*)Wgu8, PMAX, 32 * 1024, 512};
        pg8::EpiGateUp E{hdn8, rst};
        pg8::gemm_phase<pg8::EpiGateUp, pg8::MoeOrder, true, true, true, true>(lds, g, S, E);
    }
    SEAM(8);
    if (IN(9)) { KPTRS
        LAS int* pst = (LAS int*)(lds + LX_PST);
        pg8::MoeOrder S{G, bx, pst[32], pst, (LAS int*)(lds + LX_TOK)};
        pg8::Gemm g{(const bf16_t*)hdn8, (const bf16_t*)Wd8, PMAX, 32 * 1024, 256};
        pg8::EpiDown E{y8};
        pg8::gemm_phase<pg8::EpiDown, pg8::MoeOrder, true, true, false, true>(lds, g, S, E);
    }
    SEAM(9);
    if (IN(10)) { KPTRS
        const int lane = fresh_tid() & 63;
        LAS int* sb = (LAS int*)(lds + LX_PST);
        __syncthreads();
        if (tid == 0) { int s = 0; for (int e = 0; e < 32; ++e) { sb[e] = s; s += (counts[e] + 255) & ~255; } }
        __syncthreads();
        struct Meta { int e0, e1, i0, i1; float g0, g1; };
#define P10_META(M, tok) do { const int2 _e = *(const int2*)(tok_e + (tok) * 2), _i = *(const int2*)(tok_i + (tok) * 2); const float2 _g = *(const float2*)(tok_g + (tok) * 2); \
            M.e0 = _e.x; M.e1 = _e.y; M.i0 = _i.x; M.i1 = _i.y; M.g0 = _g.x; M.g1 = _g.y; } while (0)
#define P10_ROWS(A, B, C, M, tok) do { const size_t _s0 = (size_t)(sb[M.e0] + M.i0), _s1 = (size_t)(sb[M.e1] + M.i1); \
            _Pragma("unroll") for (int i = 0; i < 4; ++i) { A[i] = ((const ushort4*)(h2b + (size_t)(tok) * DM))[lane + 64 * i]; B[i] = ((const unsigned*)(y8 + _s0 * DM))[lane + 64 * i]; C[i] = ((const unsigned*)(y8 + _s1 * DM))[lane + 64 * i]; } } while (0)
        Meta m0, m1, m2; ushort4 ac[4], an[4]; unsigned bc[4], cc[4], bn[4], cn[4];
        m0 = Meta{0, 0, 0, 0, 0.f, 0.f}; m1 = m0; m2 = m0;
        if (gw < NTOK) { P10_META(m0, gw); if (gw + NGW < NTOK) P10_META(m1, gw + NGW); P10_ROWS(ac, bc, cc, m0, gw); }
        for (int tok = gw; tok < NTOK; tok += NGW) {
            const bool has1 = tok + NGW < NTOK, has2 = tok + 2 * NGW < NTOK;
            if (has2) P10_META(m2, tok + 2 * NGW);
            if (has1) P10_ROWS(an, bn, cn, m1, tok + NGW);
            const float g0 = m0.g0 * (1.0f / 16.0f), g1 = m0.g1 * (1.0f / 16.0f);
            float v[16]; float ss = 0.f;
#pragma unroll
            for (int i = 0; i < 4; ++i) {
                const ushort4 a = ac[i]; const int b = (int)bc[i], c = (int)cc[i];
                v[4 * i + 0] = bf2f(a.x) + g0 * __builtin_amdgcn_cvt_f32_fp8(b, 0) + g1 * __builtin_amdgcn_cvt_f32_fp8(c, 0);
                v[4 * i + 1] = bf2f(a.y) + g0 * __builtin_amdgcn_cvt_f32_fp8(b, 1) + g1 * __builtin_amdgcn_cvt_f32_fp8(c, 1);
                v[4 * i + 2] = bf2f(a.z) + g0 * __builtin_amdgcn_cvt_f32_fp8(b, 2) + g1 * __builtin_amdgcn_cvt_f32_fp8(c, 2);
                v[4 * i + 3] = bf2f(a.w) + g0 * __builtin_amdgcn_cvt_f32_fp8(b, 3) + g1 * __builtin_amdgcn_cvt_f32_fp8(c, 3);
#pragma unroll
                for (int j = 0; j < 4; ++j) ss += v[4 * i + j] * v[4 * i + j];
            }
            ss = wave_sum(ss);
            const float rs = rsqrtf(ss * (1.0f / DM) + EPS);
#pragma unroll
            for (int i = 0; i < 4; ++i) {
                const float4 w = ((const float4*)ln_final_w)[lane + 64 * i];
                float4 o; o.x = v[4 * i] * rs * w.x; o.y = v[4 * i + 1] * rs * w.y; o.z = v[4 * i + 2] * rs * w.z; o.w = v[4 * i + 3] * rs * w.w;
                { pg8::f32x4 o4; o4[0] = o.x; o4[1] = o.y; o4[2] = o.z; o4[3] = o.w; __builtin_nontemporal_store(o4, &((pg8::f32x4*)(out_ + (size_t)tok * DM))[lane + 64 * i]); }
            }
            m0 = m1; m1 = m2;
#pragma unroll
            for (int i = 0; i < 4; ++i) { ac[i] = an[i]; bc[i] = bn[i]; cc[i] = cn[i]; }
        }
#undef P10_META
#undef P10_ROWS
    }
#undef IN
#undef SEAM
}

static void launch_mk(hipStream_t st, int grid, const MkArgs& base, int lo, int hi, int li) {
    MkArgs a = base; a.ph_lo = lo; a.ph_hi = hi; a.li = li; a.pad = 0;
    hipLaunchKernelGGL(mk_fwd, dim3(grid), dim3(NWAVES * 64), LDS_BYTES, st, a);
}

extern "C" void kernel_launch(void* const* d_in, const int* in_sizes, int n_in, void* d_out, int out_size, void* d_ws, size_t ws_size, hipStream_t stream) {
    (void)in_sizes; (void)n_in; (void)out_size; (void)ws_size;
    static int grid = 0;
    if (grid == 0) {
        int dev = 0, cus = 0, per_cu = 0;
        (void)hipGetDevice(&dev);
        (void)hipDeviceGetAttribute(&cus, hipDeviceAttributeMultiprocessorCount, dev);
        (void)hipFuncSetAttribute((const void*)mk_fwd, hipFuncAttributeMaxDynamicSharedMemorySize, LDS_BYTES);
        (void)hipOccupancyMaxActiveBlocksPerMultiprocessor(&per_cu, (const void*)mk_fwd, NWAVES * 64, LDS_BYTES);
        (void)hipGetLastError();
        grid = cus > 0 ? cus : 256;
    }
    char* ws = (char*)d_ws;

    (void)hipMemsetAsync(ws + WS_CTL, 0, CTL_BYTES, stream);
    MkArgs a; memset(&a, 0, sizeof(a));
    for (int i = 0; i < 26; ++i) a.in[i] = (const float*)d_in[i];
    a.out = (float*)d_out; a.ws = (unsigned char*)d_ws;
    launch_mk(stream, grid, a, 0, 11, 0);
}
```

```cpp
#include <hip/hip_runtime.h>
#include <stdint.h>
#include <string.h>

typedef unsigned short bf16_t;

constexpr int BATCH = 8, SEQ = 4096, DM = 1024, NTOK = BATCH * SEQ, MEML = 256, NMEM = BATCH * MEML;
constexpr int INW = 2304, DQ0 = 0, DK0 = 512, DV0 = 1024, SQ0 = 1536, SK0 = 2048, SV0 = 2176;
constexpr int NEXP = 32, DFF = 512, PMAX = 73728;
constexpr float EPS = 1e-6f;
constexpr float LOG2E = 1.4426950408889634f;
constexpr float C2_SELF = 0.125f * LOG2E;
constexpr float C2_CROSS = 0.0625f * LOG2E;
constexpr float LAMBDA_INIT = 0.2f;

constexpr size_t ALIGN_UP(size_t x) { return (x + 255) & ~(size_t)255; }
constexpr size_t WS_CTL   = 0;
constexpr size_t CTL_BYTES = 65536;
constexpr size_t WS_RSTD0 = WS_CTL + CTL_BYTES;
constexpr size_t WS_RSTDM = WS_RSTD0 + (size_t)NTOK * 4;
constexpr size_t WS_RSTD1 = WS_RSTDM + (size_t)NMEM * 4;
constexpr size_t WS_RSTD2 = WS_RSTD1 + (size_t)NTOK * 4;
constexpr size_t WS_ROPE  = WS_RSTD2 + (size_t)NTOK * 4;
constexpr size_t WS_TOKE  = WS_ROPE + (size_t)NTOK * 32 * 8;
constexpr size_t WS_TOKI  = WS_TOKE + (size_t)NTOK * 2 * 4;
constexpr size_t WS_TOKG  = WS_TOKI + (size_t)NTOK * 2 * 4;
constexpr size_t WS_EXPL  = WS_TOKG + (size_t)NTOK * 2 * 4;
constexpr size_t WS_KVC   = WS_EXPL + (size_t)NEXP * NTOK * 4;
constexpr size_t WS_S0    = WS_KVC + (size_t)NMEM * 2048 * 2;
constexpr size_t S0_BYTES = (size_t)PMAX * DFF * 2 > (size_t)(NTOK + NMEM) * DM * 2 ? (size_t)PMAX * DFF * 2 : (size_t)(NTOK + NMEM) * DM * 2;
constexpr size_t WS_S1    = WS_S0 + S0_BYTES;
constexpr size_t S1_BYTES = (size_t)NTOK * INW * 2;
constexpr size_t WS_S2    = WS_S1 + S1_BYTES;
constexpr size_t WS_S3    = WS_S2 + (size_t)NTOK * DM * 2;
constexpr size_t WS_END   = WS_S3 + (size_t)NTOK * DM * 2;
static_assert((size_t)PMAX * DM * 2 <= S1_BYTES, "y must fit S1");
static_assert(WS_END <= (size_t)512 * 1024 * 1024, "workspace too big");
constexpr int CW_COUNTS = 12288;

__device__ __forceinline__ float bf2f(bf16_t v) { return __uint_as_float(((unsigned)v) << 16); }
__device__ __forceinline__ bf16_t f2bf(float f) { unsigned u = __float_as_uint(f); u += 0x7FFFu + ((u >> 16) & 1u); return (bf16_t)(u >> 16); }
__device__ __forceinline__ float wave_sum(float v) {
#pragma unroll
    for (int o = 32; o >= 1; o >>= 1) v += __shfl_xor(v, o);
    return v;
}
__device__ __forceinline__ float wave_max(float v) {
#pragma unroll
    for (int o = 32; o >= 1; o >>= 1) v = fmaxf(v, __shfl_xor(v, o));
    return v;
}

__device__ __forceinline__ int fresh_tid() { int t = threadIdx.x; asm volatile("" : "+v"(t)); return t; }

namespace pg8 {
#define PG8_LAS __attribute__((address_space(3)))
typedef unsigned short bf16_t;
typedef short bf16x8 __attribute__((ext_vector_type(8)));
typedef float f32x4 __attribute__((ext_vector_type(4)));
typedef unsigned u32x4 __attribute__((ext_vector_type(4)));
constexpr int BM = 256, BK = 64, HALF = 128, HTB = HALF * BK * 2  , STAGE_BYTES = 8 * HTB, NXCD = 8, WGM = 8;

__host__ __device__ __forceinline__ int lds_byte(int r, int c) { const int st = (r >> 4) * 2 + (c >> 5), rr = r & 15, cc = c & 31, ob = rr * 64 + cc * 2; return st * 1024 + (ob ^ (((ob >> 9) & 1) << 5)); }
__host__ __device__ __forceinline__ void stage_rc(int b, int& R, int& C) { const int st = b / 1024, sb = b % 1024, swz = sb ^ (((sb >> 9) & 1) << 5); R = (st >> 1) * 16 + swz / 64; C = (st & 1) * 32 + (swz % 64) / 2; }
__host__ __device__ __forceinline__ int perm32(int rho) { const int n = rho >> 4, i = rho & 15; return 8 * (i >> 2) + 4 * n + (i & 3); }

struct Unit { int pm, pn, ui; };
struct Gemm { const bf16_t* A; const bf16_t* Bt; int M, N, K; int KA = 0; };

struct StaticOrder {
    static constexpr bool WT = false;
    int nM, nN, nwg, G, c;
    __host__ __device__ void init(int M, int N, int G_, int c_) { nM = M / BM; nN = N / BM; nwg = nM * nN; G = G_; c = c_; }
    __host__ __device__ __forceinline__ bool next(int i, Unit& u) const {
        const long L = (long)i * G + c; if (L >= nwg) return false;
        int wgid = (int)L; { const int q = nwg / NXCD, r = nwg % NXCD, xcd = wgid % NXCD, off = wgid / NXCD; wgid = (xcd < r ? xcd * (q + 1) : r * (q + 1) + (xcd - r) * q) + off; }
        const int nig = WGM * nN, gid = wgid / nig, fm = gid * WGM, gsz = (nM - fm) < WGM ? (nM - fm) : WGM;
        u.pm = fm + ((wgid % nig) % gsz); u.pn = (wgid % nig) / gsz; return true;
    }
    __device__ __forceinline__ void a_ready(const Unit&) const {}
    __device__ __forceinline__ void done(const Unit&) const {}
};

__device__ __forceinline__ unsigned cvt_pk_bf16(float lo, float hi) { unsigned r; asm volatile("v_cvt_pk_bf16_f32 %0, %1, %2" : "=v"(r) : "v"(lo), "v"(hi)); return r; }
typedef float f32x2 __attribute__((ext_vector_type(2)));

template <class Epi, class Sched, bool ALIGN_EPI = false, bool SP2 = false, bool GATHER = false, bool FP8 = false>
__device__ __forceinline__ void gemm_phase(PG8_LAS unsigned char* lds, const Gemm g, const Sched& S, const Epi& E) {
    const int tid = fresh_tid(), wid = __builtin_amdgcn_readfirstlane(tid >> 6), lane = tid & 63, wr = wid >> 2, wc = wid & 3, fr = lane & 15, fq = lane >> 4;
    const int K = g.K, nt = K / BK, KA = g.KA ? g.KA : K;
    unsigned voffA[2], voffB[2];
#pragma unroll
    for (int i = 0; i < 2; ++i) { int R, C; stage_rc(tid * 16 + i * 8192, R, C); const int Rb = Epi::PERM ? ((R & ~31) + perm32(R & 31)) : R;
        voffA[i] = (unsigned)(R * KA + C) * 2u; voffB[i] = (unsigned)(Rb * K + C) * 2u; }
    const int pg8_sc7f = 0x7f7f7f7f;
    unsigned gC[2][2] = {{0u, 0u}, {0u, 0u}}, gN[2][2] = {{0u, 0u}, {0u, 0u}};
#define PG8_GOFF(dst, uu) do { _Pragma("unroll") for (int _i = 0; _i < 2; ++_i) { int _R, _C; stage_rc(tid * 16 + _i * 8192, _R, _C); \
        dst[0][_i] = (unsigned)S.arow(uu, _R) * (unsigned)(K * 2) + (unsigned)_C * 2u; dst[1][_i] = (unsigned)S.arow(uu, HALF + _R) * (unsigned)(K * 2) + (unsigned)_C * 2u; } } while (0)
    const size_t kstep = (size_t)(BK * 2);
    const size_t hstep = (size_t)HALF * K * 2;
    const size_t tstep = 2 * hstep;
    const size_t hstepA = (size_t)HALF * KA * 2, tstepA = 2 * hstepA;
    const unsigned ldsw = (unsigned)wid * 1024u;
    const int aoff = lds_byte(wr * 64 + fr, fq * 8), boff = lds_byte(wc * 32 + fr, fq * 8);
#define PG8_SA(b, h) (((b) * 2 + (h)) * HTB)
#define PG8_SB(b, h) ((4 + (b) * 2 + (h)) * HTB)
#define PG8_STAGE(bufoff, gbase, voff) do { _Pragma("unroll") for (int _i = 0; _i < 2; ++_i) \
        __builtin_amdgcn_global_load_lds((const unsigned*)((const char*)(gbase) + (voff)[_i]), (PG8_LAS unsigned*)(lds + (bufoff) + ldsw + _i * 8192), 16, 0, 0); } while (0)
#define PG8_STAGE_A(bufoff, gbase, h, nx) do { _Pragma("unroll") for (int _i = 0; _i < 2; ++_i) { \
        const unsigned _o = GATHER ? ((nx) ? gN[h][_i] : gC[h][_i]) : voffA[_i]; \
        __builtin_amdgcn_global_load_lds((const unsigned*)((const char*)(gbase) + (GATHER ? (size_t)0 : (size_t)(h) * hstepA) + _o), (PG8_LAS unsigned*)(lds + (bufoff) + ldsw + _i * 8192), 16, 0, 0); } } while (0)
#define PG8_LDA(dst, b, h) do { _Pragma("unroll") for (int m = 0; m < 4; ++m) _Pragma("unroll") for (int k = 0; k < 2; ++k) dst[m][k] = *(const PG8_LAS bf16x8*)(lds + PG8_SA(b, h) + aoff + m * 2048 + k * 1024); } while (0)
#define PG8_LDB(dst, b, h) do { _Pragma("unroll") for (int n = 0; n < 2; ++n) _Pragma("unroll") for (int k = 0; k < 2; ++k) dst[n][k] = *(const PG8_LAS bf16x8*)(lds + PG8_SB(b, h) + boff + n * 2048 + k * 1024); } while (0)
#define PG8_MMA(ai, bj, At, Bt) do { __builtin_amdgcn_s_setprio(1); _Pragma("unroll") for (int m = 0; m < 4; ++m) _Pragma("unroll") for (int n = 0; n < 2; ++n) { \
        if constexpr (FP8) { typedef int v4i_ __attribute__((ext_vector_type(4))); typedef int v8i_ __attribute__((ext_vector_type(8))); \
            const v4i_ _b0 = __builtin_bit_cast(v4i_, Bt[n][0]), _b1 = __builtin_bit_cast(v4i_, Bt[n][1]), _a0 = __builtin_bit_cast(v4i_, At[m][0]), _a1 = __builtin_bit_cast(v4i_, At[m][1]); \
            const v8i_ _bb = __builtin_shufflevector(_b0, _b1, 0, 1, 2, 3, 4, 5, 6, 7), _aa = __builtin_shufflevector(_a0, _a1, 0, 1, 2, 3, 4, 5, 6, 7); \
            asm("v_mfma_scale_f32_16x16x128_f8f6f4 %0, %1, %2, %0, %3, %3 op_sel_hi:[0,0,0]" : "+v"(acc[ai][bj][m][n]) : "v"(_bb), "v"(_aa), "v"(pg8_sc7f)); } \
        else { _Pragma("unroll") for (int k = 0; k < 2; ++k) acc[ai][bj][m][n] = __builtin_amdgcn_mfma_f32_16x16x32_bf16(Bt[n][k], At[m][k], acc[ai][bj][m][n], 0, 0, 0); } } \
        __builtin_amdgcn_s_setprio(0); } while (0)
#define PG8_WAIT_V(n) asm volatile("s_waitcnt vmcnt(" #n ")" ::: "memory")
#define PG8_WAIT_L(n) asm volatile("s_waitcnt lgkmcnt(" #n ")" ::: "memory")
#define PG8_BAR __builtin_amdgcn_s_barrier()
#define PG8_SCHED __builtin_amdgcn_sched_barrier(0)
    Unit cur, nxt; int ui = 0;
    if (!S.next(0, cur)) return;
    f32x4 acc[2][2][4][2];
#pragma unroll
    for (int a = 0; a < 2; ++a)
#pragma unroll
        for (int b = 0; b < 2; ++b)
#pragma unroll
            for (int m = 0; m < 4; ++m)
#pragma unroll
                for (int n = 0; n < 2; ++n) { acc[a][b][m][n] = (f32x4){0.f, 0.f, 0.f, 0.f}; if constexpr (FP8) asm volatile("" : "+v"(acc[a][b][m][n])); }
    bf16x8 At[4][2], B0[2][2], B1[2][2];
    const char* cA = GATHER ? (const char*)g.A : (const char*)g.A + (size_t)cur.pm * tstepA; const char* cB = (const char*)g.Bt + (size_t)cur.pn * tstep;
    if constexpr (GATHER) { PG8_GOFF(gC, cur); }
    S.a_ready(cur);
    if constexpr (SP2) {
        PG8_STAGE(PG8_SB(0, 0), cB, voffB); PG8_STAGE(PG8_SB(0, 1), cB + hstep, voffB); PG8_STAGE_A(PG8_SA(0, 0), cA, 0, false); PG8_STAGE_A(PG8_SA(0, 1), cA, 1, false);
        if (wr == 1) PG8_BAR;
        PG8_WAIT_V(2); PG8_BAR;
        PG8_STAGE(PG8_SB(1, 0), cB + kstep, voffB); PG8_STAGE_A(PG8_SA(1, 0), cA + kstep, 0, false); PG8_STAGE(PG8_SB(1, 1), cB + hstep + kstep, voffB);
        PG8_WAIT_V(6); PG8_BAR;
    } else {
        PG8_STAGE(PG8_SB(0, 0), cB, voffB); PG8_STAGE_A(PG8_SA(0, 0), cA, 0, false); PG8_STAGE(PG8_SB(0, 1), cB + hstep, voffB); PG8_STAGE_A(PG8_SA(0, 1), cA, 1, false);
        if (wr == 1) PG8_BAR;
        PG8_WAIT_V(4); PG8_BAR;
        PG8_STAGE(PG8_SB(1, 0), cB + kstep, voffB); PG8_STAGE_A(PG8_SA(1, 0), cA + kstep, 0, false); PG8_STAGE(PG8_SB(1, 1), cB + hstep + kstep, voffB);
        PG8_WAIT_V(6); PG8_BAR;
    }
    for (;;) {
        const bool has_next = S.next(ui + 1, nxt);
        const char* nA = GATHER ? cA : (has_next ? (const char*)g.A + (size_t)nxt.pm * tstepA : cA); const char* nB = has_next ? (const char*)g.Bt + (size_t)nxt.pn * tstep : cB;
        for (int t = 0; t < nt; t += 2) {
            const bool last = (t == nt - 2);
            const char* a1 = cA + (size_t)(t + 1) * kstep;
            const char* a2 = last ? nA : cA + (size_t)(t + 2) * kstep; const char* b2 = last ? nB : cB + (size_t)(t + 2) * kstep;
            const char* a3 = a2 + kstep; const char* b3 = b2 + kstep;
            if (last && has_next) S.a_ready(nxt);
            if constexpr (GATHER) { if (last) { if (has_next) { PG8_GOFF(gN, nxt); } else { gN[0][0] = gC[0][0]; gN[0][1] = gC[0][1]; gN[1][0] = gC[1][0]; gN[1][1] = gC[1][1]; } } }
            if constexpr (SP2) {
            PG8_LDB(B0, 0, 0); PG8_LDB(B1, 0, 1); PG8_SCHED; PG8_LDA(At, 0, 0); PG8_STAGE_A(PG8_SA(1, 1), a1, 1, false);
            PG8_WAIT_V(8); PG8_WAIT_L(0); PG8_BAR; PG8_MMA(0, 0, At, B0); PG8_MMA(0, 1, At, B1); PG8_BAR; PG8_SCHED;
            PG8_LDA(At, 0, 1); PG8_STAGE(PG8_SB(0, 0), b2, voffB); PG8_STAGE(PG8_SB(0, 1), b2 + hstep, voffB); PG8_STAGE_A(PG8_SA(0, 0), a2, 0, last);
            PG8_WAIT_V(8); PG8_WAIT_L(0); PG8_BAR; PG8_MMA(1, 0, At, B0); PG8_MMA(1, 1, At, B1); PG8_BAR; PG8_SCHED;
            PG8_LDB(B0, 1, 0); PG8_LDB(B1, 1, 1); PG8_SCHED; PG8_LDA(At, 1, 0); PG8_STAGE_A(PG8_SA(0, 1), a2, 1, last);
            PG8_WAIT_V(8); PG8_WAIT_L(0); PG8_BAR; PG8_MMA(0, 0, At, B0); PG8_MMA(0, 1, At, B1); PG8_BAR; PG8_SCHED;
            PG8_LDA(At, 1, 1); PG8_STAGE(PG8_SB(1, 0), b3, voffB); PG8_STAGE(PG8_SB(1, 1), b3 + hstep, voffB); PG8_STAGE_A(PG8_SA(1, 0), a3, 0, last);
            PG8_WAIT_V(8); PG8_WAIT_L(0); PG8_BAR; PG8_MMA(1, 0, At, B0); PG8_MMA(1, 1, At, B1); PG8_BAR; PG8_SCHED;
            } else {
            PG8_LDB(B0, 0, 0); PG8_SCHED; PG8_LDA(At, 0, 0); PG8_STAGE_A(PG8_SA(1, 1), a1, 1, false);
            PG8_WAIT_L(8); PG8_BAR; PG8_WAIT_L(0); PG8_MMA(0, 0, At, B0); PG8_BAR; PG8_SCHED;
            PG8_LDB(B1, 0, 1); PG8_STAGE(PG8_SB(0, 0), b2, voffB);
            PG8_BAR; PG8_WAIT_L(0); PG8_MMA(0, 1, At, B1); PG8_BAR;
            PG8_LDA(At, 0, 1); PG8_STAGE_A(PG8_SA(0, 0), a2, 0, last);
            PG8_BAR; PG8_WAIT_L(0); PG8_MMA(1, 0, At, B0); PG8_BAR; PG8_SCHED;
            PG8_STAGE(PG8_SB(0, 1), b2 + hstep, voffB);
            PG8_WAIT_V(6); PG8_BAR; PG8_MMA(1, 1, At, B1); PG8_BAR;
            PG8_LDB(B0, 1, 0); PG8_SCHED; PG8_LDA(At, 1, 0); PG8_STAGE_A(PG8_SA(0, 1), a2, 1, last);
            PG8_WAIT_L(8); PG8_BAR; PG8_WAIT_L(0); PG8_MMA(0, 0, At, B0); PG8_BAR; PG8_SCHED;
            PG8_LDB(B1, 1, 1); PG8_STAGE(PG8_SB(1, 0), b3, voffB);
            PG8_BAR; PG8_WAIT_L(0); PG8_MMA(0, 1, At, B1); PG8_BAR;
            PG8_LDA(At, 1, 1); PG8_STAGE_A(PG8_SA(1, 0), a3, 0, last);
            PG8_BAR; PG8_WAIT_L(0); PG8_MMA(1, 0, At, B0); PG8_BAR; PG8_SCHED;
            PG8_STAGE(PG8_SB(1, 1), b3 + hstep, voffB);
            PG8_WAIT_V(6); PG8_BAR; PG8_MMA(1, 1, At, B1); PG8_BAR;
            }
        }
        if constexpr (ALIGN_EPI) { if (wr == 0) PG8_BAR; }
        if constexpr (FP8) asm volatile("s_nop 15\n\ts_nop 15" ::: "memory");
        if constexpr (!Epi::AFTER_DRAIN) { E(acc, cur, wr, wc, fr, fq); S.done(cur); }
        if (!has_next) break;
#pragma unroll
        for (int a = 0; a < 2; ++a)
#pragma unroll
            for (int b = 0; b < 2; ++b)
#pragma unroll
                for (int m = 0; m < 4; ++m)
#pragma unroll
                    for (int n = 0; n < 2; ++n) { acc[a][b][m][n] = (f32x4){0.f, 0.f, 0.f, 0.f}; if constexpr (FP8) asm volatile("" : "+v"(acc[a][b][m][n])); }
        cur = nxt; cA = nA; cB = nB; ++ui;
        if constexpr (GATHER) { gC[0][0] = gN[0][0]; gC[0][1] = gN[0][1]; gC[1][0] = gN[1][0]; gC[1][1] = gN[1][1]; }
        if constexpr (ALIGN_EPI) { if (wr == 1) PG8_BAR; }
    }
    PG8_WAIT_V(0);
    if constexpr (!ALIGN_EPI) { if (wr == 0) PG8_BAR; }
    PG8_BAR;
    if constexpr (Epi::AFTER_DRAIN) { E.fused(acc, cur, wr, wc, fr, fq, lds, wid, lane); S.done(cur); }
#undef PG8_SA
#undef PG8_SB
#undef PG8_STAGE
#undef PG8_STAGE_A
#undef PG8_GOFF
#undef PG8_LDA
#undef PG8_LDB
#undef PG8_MMA
#undef PG8_WAIT_V
#undef PG8_WAIT_L
#undef PG8_BAR
#undef PG8_SCHED
}


__device__ __forceinline__ void order_map(int L, int nM, int nN, int& pm, int& pn) {
    const int nwg = nM * nN; int wgid = L; { const int q = nwg / NXCD, r = nwg % NXCD, xcd = wgid % NXCD, off = wgid / NXCD; wgid = (xcd < r ? xcd * (q + 1) : r * (q + 1) + (xcd - r) * q) + off; }
    const int nig = WGM * nN, gid = wgid / nig, fm = gid * WGM, gsz = (nM - fm) < WGM ? (nM - fm) : WGM;
    pm = fm + ((wgid % nig) % gsz); pn = (wgid % nig) / gsz;
}
struct StaticOrderUi : StaticOrder {
    __device__ __forceinline__ bool next(int i, Unit& u) const { u.ui = i; return StaticOrder::next(i, u); }
};
struct InProjOrder {
    int G, c;
    __device__ __forceinline__ bool next(int i, Unit& u) const {
        const int L = i * G + c; u.ui = i;
        if (L < 1152) { order_map(L, 128, 9, u.pm, u.pn); return true; }
        if (L < 1152 + 64) { int a, b2; order_map(L - 1152, 8, 8, a, b2); u.pm = 128 + b2; u.pn = 9 + a; return true; }
        return false;
    }
    __device__ __forceinline__ void a_ready(const Unit&) const {}
    __device__ __forceinline__ void done(const Unit&) const {}
};
constexpr int DEP_STRIDE = 8;
__device__ __forceinline__ void dep_signal(unsigned* cnt, int pm) {
    asm volatile("s_waitcnt vmcnt(0)" ::: "memory");
    if (__lane_id() == 0) __hip_atomic_fetch_add(cnt + pm * DEP_STRIDE, 1u, __ATOMIC_RELAXED, __HIP_MEMORY_SCOPE_AGENT);
}
__device__ __forceinline__ void dep_wait(const unsigned* cnt, int pm, unsigned want) {
    for (unsigned spins = 0; spins < (1u << 22); ++spins) {
        if ((unsigned)__builtin_amdgcn_readfirstlane(__hip_atomic_load(cnt + pm * DEP_STRIDE, __ATOMIC_RELAXED, __HIP_MEMORY_SCOPE_AGENT)) >= want) break;
        __builtin_amdgcn_s_sleep(1);
    }
    __builtin_amdgcn_fence(__ATOMIC_ACQUIRE, "agent");
}
struct MoeOrderX {
    int G, c, nP;
    const PG8_LAS int* pst; const PG8_LAS int* tokt;
    bool rev; unsigned* cnt; bool waits;
    __device__ __forceinline__ bool next(int i, Unit& u) const {
        int sp, j;
        if (G & 7) { j = i * G + c; if (j >= 4 * nP) return false; sp = j >> 2; }
        else { const int nl = G >> 3, xcd = c & 7, r = c >> 3, base = (nP * xcd) >> 3, np = ((nP * (xcd + 1)) >> 3) - base;
            j = i * nl + (rev ? nl - 1 - r : r); if (j >= 4 * np) return false; sp = base + (j >> 2); }
        int e = 0;
#pragma unroll 1
        for (int q = 1; q < 32; ++q) e += (pst[q] <= sp) ? 1 : 0;
        u.pm = sp; u.pn = e * 4 + (j & 3); u.ui = i; return true;
    }
    __device__ __forceinline__ int arow(const Unit& u, int R) const { return tokt[u.ui * 256 + R]; }
    __device__ __forceinline__ void a_ready(const Unit& u) const { if (cnt && waits) dep_wait(cnt, u.pm, 32u); }
    __device__ __forceinline__ void done(const Unit& u) const { if (cnt && !waits) dep_signal(cnt, u.pm); }
};
struct MoeOrder {
    int G, c, nP;
    const PG8_LAS int* pst;
    const PG8_LAS int* tokt;
    __device__ __forceinline__ bool next(int i, Unit& u) const {
        const int L = i * G + c; if (L >= nP * 4) return false;
        int sp, pnl; order_map(L, nP, 4, sp, pnl);
        int e = 0;
#pragma unroll 1
        for (int j = 1; j < 32; ++j) e += (pst[j] <= sp) ? 1 : 0;
        u.pm = sp; u.pn = e * 4 + pnl; u.ui = i; return true;
    }
    __device__ __forceinline__ int arow(const Unit& u, int R) const { return tokt[u.ui * 256 + R]; }
    __device__ __forceinline__ void a_ready(const Unit&) const {}
    __device__ __forceinline__ void done(const Unit&) const {}
};

typedef unsigned u32x4v __attribute__((ext_vector_type(4)));
__device__ __forceinline__ u32x4v pack8(const f32x4& a, const f32x4& b) { u32x4v w; w.x = cvt_pk_bf16(a[0], a[1]); w.y = cvt_pk_bf16(a[2], a[3]); w.z = cvt_pk_bf16(b[0], b[1]); w.w = cvt_pk_bf16(b[2], b[3]); return w; }
__device__ __forceinline__ void unpack8(const u32x4v w, f32x4& a, f32x4& b) {
    a[0] = __uint_as_float(w.x << 16); a[1] = __uint_as_float(w.x & 0xffff0000u); a[2] = __uint_as_float(w.y << 16); a[3] = __uint_as_float(w.y & 0xffff0000u);
    b[0] = __uint_as_float(w.z << 16); b[1] = __uint_as_float(w.z & 0xffff0000u); b[2] = __uint_as_float(w.w << 16); b[3] = __uint_as_float(w.w & 0xffff0000u);
}

#define E4M3_CLAMP(x) __builtin_amdgcn_fmed3f((x), -448.0f, 448.0f)
__device__ __forceinline__ uint2 pack8_fp8(const f32x4& a, const f32x4& b) {
    int lo = 0, hi = 0;
    lo = __builtin_amdgcn_cvt_pk_fp8_f32(E4M3_CLAMP(a[0]), E4M3_CLAMP(a[1]), lo, false); lo = __builtin_amdgcn_cvt_pk_fp8_f32(E4M3_CLAMP(a[2]), E4M3_CLAMP(a[3]), lo, true);
    hi = __builtin_amdgcn_cvt_pk_fp8_f32(E4M3_CLAMP(b[0]), E4M3_CLAMP(b[1]), hi, false); hi = __builtin_amdgcn_cvt_pk_fp8_f32(E4M3_CLAMP(b[2]), E4M3_CLAMP(b[3]), hi, true);
    return make_uint2((unsigned)lo, (unsigned)hi);
}
struct EpiInProj {
    static constexpr bool PERM = true, AFTER_DRAIN = false;
    bf16_t* projr; bf16_t* kvc; const PG8_LAS float* rst; const unsigned* tab;
    __device__ __forceinline__ void operator()(const f32x4 (&acc)[2][2][4][2], const Unit& u, int wr, int wc, int fr, int fq) const {
        const int rl0 = wr * 64 + fr, row0 = u.pm * BM + rl0, pn = u.pn;
        const PG8_LAS float* rsu = rst + u.ui * 256 + rl0;
        if (pn >= 9) {
            const int col0 = (pn - 9) * 256 + wc * 32 + 8 * fq;
#pragma unroll
            for (int ai = 0; ai < 2; ++ai)
#pragma unroll
                for (int m = 0; m < 4; ++m) { const int r = row0 - 32768 + ai * HALF + m * 16; const float rs = rsu[ai * HALF + m * 16];
#pragma unroll
                    for (int bj = 0; bj < 2; ++bj) *(u32x4v*)(kvc + (size_t)r * 2112 + col0 + bj * HALF) = pack8(acc[ai][bj][m][0] * rs, acc[ai][bj][m][1] * rs); }
        } else if (pn == 4 || pn == 5 || (pn == 8 && wc >= 2)) {
            const int c0 = (pn == 8) ? (2176 + (wc - 2) * 32 + 8 * fq) : (1024 + (pn - 4) * 256 + wc * 32 + 8 * fq), cstep = (pn == 8) ? 64 : 128;
#pragma unroll
            for (int ai = 0; ai < 2; ++ai)
#pragma unroll
                for (int m = 0; m < 4; ++m) { const int r = row0 + ai * HALF + m * 16; const float rs = rsu[ai * HALF + m * 16];
#pragma unroll
                    for (int bj = 0; bj < 2; ++bj) *(u32x4v*)(projr + (size_t)r * 2304 + c0 + bj * cstep) = pack8(acc[ai][bj][m][0] * rs, acc[ai][bj][m][1] * rs); }
        } else {
            int cb; float sc = 1.0f;
            if (pn < 2) { cb = pn * 256; sc = 0.125f * 1.4426950408889634f; } else if (pn < 4) { cb = 512 + (pn - 2) * 256; } else if (pn < 8) { cb = 1536 + (pn - 6) * 256; sc = 0.125f * 1.4426950408889634f; } else { cb = 2048; }
            const int c0 = cb + wc * 64 + 8 * fq;
#pragma unroll
            for (int ai = 0; ai < 2; ++ai) {
                u32x4v tw[4][2];
#pragma unroll
                for (int m = 0; m < 4; ++m) { const u32x4v* tp = (const u32x4v*)(tab + (size_t)(row0 + ai * HALF + m * 16) * 32 + 8 * fq); tw[m][0] = tp[0]; tw[m][1] = tp[1]; }
#pragma unroll
                for (int m = 0; m < 4; ++m) { const int r = row0 + ai * HALF + m * 16; const float rs = rsu[ai * HALF + m * 16] * sc;
                    const u32x4v ta = tw[m][0], tb = tw[m][1];
                    const f32x4 cA = {__uint_as_float(ta.x << 16), __uint_as_float(ta.y << 16), __uint_as_float(ta.z << 16), __uint_as_float(ta.w << 16)};
                    const f32x4 sA = {__uint_as_float(ta.x & 0xffff0000u), __uint_as_float(ta.y & 0xffff0000u), __uint_as_float(ta.z & 0xffff0000u), __uint_as_float(ta.w & 0xffff0000u)};
                    const f32x4 cB = {__uint_as_float(tb.x << 16), __uint_as_float(tb.y << 16), __uint_as_float(tb.z << 16), __uint_as_float(tb.w << 16)};
                    const f32x4 sB = {__uint_as_float(tb.x & 0xffff0000u), __uint_as_float(tb.y & 0xffff0000u), __uint_as_float(tb.z & 0xffff0000u), __uint_as_float(tb.w & 0xffff0000u)};
                    const f32x4 x1a = acc[ai][0][m][0] * rs, x1b = acc[ai][0][m][1] * rs, x2a = acc[ai][1][m][0] * rs, x2b = acc[ai][1][m][1] * rs;
                    *(u32x4v*)(projr + (size_t)r * 2304 + c0) = pack8(x1a * cA - x2a * sA, x1b * cB - x2b * sB);
                    *(u32x4v*)(projr + (size_t)r * 2304 + c0 + 32) = pack8(x2a * cA + x1a * sA, x2b * cB + x1b * sB); }
            }
        }
    }
};
struct EpiRes {
    static constexpr bool PERM = true, AFTER_DRAIN = false;
    const bf16_t* res; bf16_t* out; float* ssp; unsigned char* out8; float asc; int p8;
    __device__ __forceinline__ void operator()(const f32x4 (&acc)[2][2][4][2], const Unit& u, int wr, int wc, int fr, int fq) const {
        const int row0 = u.pm * BM + wr * 64 + fr, col0 = u.pn * BM + wc * 32 + 8 * fq;
        u32x4v rv[4][2], ov[4][2]; uint2 o8[4][2]; float sv[4];
#define ER_LOAD(ai) do { _Pragma("unroll") for (int m = 0; m < 4; ++m) _Pragma("unroll") for (int bj = 0; bj < 2; ++bj) rv[m][bj] = __builtin_nontemporal_load((const u32x4v*)(res + (size_t)(row0 + (ai) * HALF + m * 16) * 1024 + col0 + bj * HALF)); } while (0)
#define ER_CALC(ai) do { _Pragma("unroll") for (int m = 0; m < 4; ++m) { float ss = 0.f; \
            _Pragma("unroll") for (int bj = 0; bj < 2; ++bj) { f32x4 ra, rb; unpack8(rv[m][bj], ra, rb); const f32x4 va = acc[ai][bj][m][0] * asc + ra, vb = acc[ai][bj][m][1] * asc + rb; \
                ss += (va[0] * va[0] + va[1] * va[1]) + (va[2] * va[2] + va[3] * va[3]) + (vb[0] * vb[0] + vb[1] * vb[1]) + (vb[2] * vb[2] + vb[3] * vb[3]); ov[m][bj] = pack8(va, vb); if (out8) o8[m][bj] = pack8_fp8(va, vb); } \
            ss += __shfl_xor(ss, 16); ss += __shfl_xor(ss, 32); sv[m] = ss; } } while (0)
#define ER_STORE(ai) do { _Pragma("unroll") for (int m = 0; m < 4; ++m) { const int r = row0 + (ai) * HALF + m * 16; \
            _Pragma("unroll") for (int bj = 0; bj < 2; ++bj) { *(u32x4v*)(out + (size_t)r * 1024 + col0 + bj * HALF) = ov[m][bj]; if (out8) *(uint2*)(out8 + (size_t)r * p8 + col0 + bj * HALF) = o8[m][bj]; } \
            if (fq == 0) ssp[(size_t)r * 16 + u.pn * 4 + wc] = sv[m]; } } while (0)
        ER_LOAD(0); ER_CALC(0); ER_LOAD(1); ER_STORE(0); ER_CALC(1); ER_STORE(1);
#undef ER_LOAD
#undef ER_CALC
#undef ER_STORE
    }
};
__device__ __forceinline__ float rstd_from_ssp(const float* ssp, int r) {
    const f32x4* p = (const f32x4*)(ssp + (size_t)r * 16); const f32x4 a = p[0], b = p[1], c = p[2], d = p[3];
    const float s = ((a[0] + a[1]) + (a[2] + a[3])) + ((b[0] + b[1]) + (b[2] + b[3])) + ((c[0] + c[1]) + (c[2] + c[3])) + ((d[0] + d[1]) + (d[2] + d[3]));
    return rsqrtf(s * (1.0f / 1024.0f) + 1e-6f);
}
struct EpiScale {
    static constexpr bool PERM = true, AFTER_DRAIN = false;
    bf16_t* out; const PG8_LAS float* rst;
    __device__ __forceinline__ void operator()(const f32x4 (&acc)[2][2][4][2], const Unit& u, int wr, int wc, int fr, int fq) const {
        const int rl0 = wr * 64 + fr, row0 = u.pm * BM + rl0, col0 = u.pn * BM + wc * 32 + 8 * fq;
#pragma unroll
        for (int ai = 0; ai < 2; ++ai)
#pragma unroll
            for (int m = 0; m < 4; ++m) { const int r = row0 + ai * HALF + m * 16; const float rs = rst[u.ui * 256 + rl0 + ai * HALF + m * 16];
#pragma unroll
                for (int bj = 0; bj < 2; ++bj) *(u32x4v*)(out + (size_t)r * 1024 + col0 + bj * HALF) = pack8(acc[ai][bj][m][0] * rs, acc[ai][bj][m][1] * rs); }
    }
};
struct EpiGateUp {
    static constexpr bool PERM = true, AFTER_DRAIN = false;
    unsigned char* hdn; const PG8_LAS float* rst;
    __device__ __forceinline__ void operator()(const f32x4 (&acc)[2][2][4][2], const Unit& u, int wr, int wc, int fr, int fq) const {
        const int rl0 = wr * 64 + fr, col0 = (u.pn & 3) * 128 + wc * 32 + 8 * fq;
#pragma unroll
        for (int ai = 0; ai < 2; ++ai)
#pragma unroll
            for (int m = 0; m < 4; ++m) { const int rl = rl0 + ai * HALF + m * 16; const float rs = rst[u.ui * 256 + rl] * (1.0f / 64.0f);
                f32x4 h[2];
#pragma unroll
                for (int n = 0; n < 2; ++n) { const f32x4 g = acc[ai][0][m][n] * rs, up = acc[ai][1][m][n] * rs;
#pragma unroll
                    for (int j = 0; j < 4; ++j) h[n][j] = g[j] * __builtin_amdgcn_rcpf(1.0f + __builtin_amdgcn_exp2f(-1.4426950408889634f * g[j])) * up[j]; }
                *(uint2*)(hdn + (size_t)(u.pm * BM + rl) * 512 + col0) = pack8_fp8(h[0] * 8.0f, h[1] * 8.0f); }
    }
};
struct EpiDown {
    static constexpr bool PERM = true, AFTER_DRAIN = false;
    unsigned char* y;
    __device__ __forceinline__ void operator()(const f32x4 (&acc)[2][2][4][2], const Unit& u, int wr, int wc, int fr, int fq) const {
        const int row0 = u.pm * BM + wr * 64 + fr, col0 = (u.pn & 3) * BM + wc * 32 + 8 * fq;
#pragma unroll
        for (int ai = 0; ai < 2; ++ai)
#pragma unroll
            for (int m = 0; m < 4; ++m) { const int r = row0 + ai * HALF + m * 16;
#pragma unroll
                for (int bj = 0; bj < 2; ++bj) *(uint2*)(y + (size_t)r * 1024 + col0 + bj * HALF) = pack8_fp8(acc[ai][bj][m][0] * (1.0f / 16.0f), acc[ai][bj][m][1] * (1.0f / 16.0f)); }
    }
};
}


namespace att {
#define ALAS __attribute__((address_space(3)))
typedef short bf16x8 __attribute__((ext_vector_type(8)));
typedef short s16x4 __attribute__((ext_vector_type(4)));
typedef float f32x16 __attribute__((ext_vector_type(16)));
typedef unsigned u32x4 __attribute__((ext_vector_type(4)));
typedef float f32x2_t __attribute__((ext_vector_type(2)));
typedef __bf16 bf16x2_t __attribute__((ext_vector_type(2)));
typedef short v4i16_t __attribute__((ext_vector_type(4)));
__device__ __forceinline__ unsigned cvtpk(float lo, float hi) { f32x2_t v = {lo, hi}; bf16x2_t b = __builtin_convertvector(v, bf16x2_t); return __builtin_bit_cast(unsigned, b); }
__device__ __forceinline__ s16x4 vtr(const ALAS unsigned char* p) { return __builtin_bit_cast(s16x4, __builtin_amdgcn_ds_read_tr16_b64_v4i16((ALAS v4i16_t*)p)); }
__device__ __forceinline__ int crow(int r, int hi) { return (r & 3) + 8 * (r >> 2) + 4 * hi; }
__device__ __forceinline__ float amax3(float a, float b, float c) { float r; asm("v_max3_f32 %0, %1, %2, %3" : "=v"(r) : "v"(a), "v"(b), "v"(c)); return r; }
__device__ __forceinline__ float amax2(float a, float b) { float r; asm("v_max_f32_e32 %0, %1, %2" : "=v"(r) : "v"(a), "v"(b)); return r; }
__device__ __forceinline__ float xhalf_max(float x) { const auto rr = __builtin_amdgcn_permlane32_swap(__float_as_uint(x), __float_as_uint(x), false, false); return fmaxf(__uint_as_float(rr[0]), __uint_as_float(rr[1])); }
__device__ __forceinline__ float xhalf_sum(float x) { const auto rr = __builtin_amdgcn_permlane32_swap(__float_as_uint(x), __float_as_uint(x), false, false); return __uint_as_float(rr[0]) + __uint_as_float(rr[1]); }
template <int K> __device__ __forceinline__ float swz_xor(float x) { return __uint_as_float((unsigned)__builtin_amdgcn_ds_swizzle((int)__float_as_uint(x), (K << 10) | 0x1f)); }
__device__ __forceinline__ float aadd(float a, float b) { float r; asm("v_add_f32_e32 %0, %1, %2" : "=v"(r) : "v"(a), "v"(b)); return r; }
__device__ __forceinline__ float aadd_t(float a, float b) { float r; asm("s_nop 0\n\tv_add_f32_e32 %0, %1, %2" : "=v"(r) : "v"(a), "v"(b)); return r; }
#define CROWC(r) (((r) & 3) + 8 * ((r) >> 2))
constexpr int SCR_OFF = 66560;
constexpr float THR = 8.0f;

}


namespace att {
__device__ __forceinline__ void diff_unit(ALAS unsigned char* lds, const bf16_t* __restrict__ projr, bf16_t* __restrict__ ocat, int b, int hh, int qb, float lam, const float* __restrict__ subln_w) {
    constexpr int KBB = 16384, VBB = 16384, VOFF = 32768, NDB = 4;
    const int tid = fresh_tid(), lane = tid & 63;
    const int r32 = lane & 31, hi = lane >> 5, w = __builtin_amdgcn_readfirstlane(tid >> 6);
    const int comp = w >> 2, qsub = w & 3;
    const int q0 = qb * 128 + qsub * 32;
    const size_t rowbase = (size_t)b * SEQ;
    const int t1 = 2 * qb + 2;
    bf16x8 qf[4];
#pragma unroll
    for (int d0 = 0; d0 < 4; ++d0) qf[d0] = *(const bf16x8*)(projr + (rowbase + q0 + r32) * INW + DQ0 + hh * 128 + comp * 64 + 16 * d0 + 8 * hi);
    const char* ksrc = (const char*)(projr + rowbase * INW + DK0 + hh * 128 + w * 8);
    const char* vsrc = (const char*)(projr + (rowbase + (w & 3) * 16) * INW + DV0 + hh * 128 + (w >> 2) * 32);
#define DF_KOFF ((unsigned)lane * (INW * 2))
#define DF_VOFF ((unsigned)(lane >> 2) * (INW * 2) + (unsigned)(lane & 3) * 16)
#define DF_DMAK(t) do { const char* _s = ksrc + (size_t)(t) * (64 * INW * 2); ALAS unsigned* _d = (ALAS unsigned*)(lds + ((t) & 1) * KBB + w * 1024); \
        __builtin_amdgcn_global_load_lds((const unsigned*)(_s + DF_KOFF), _d, 16, 0, 0); __builtin_amdgcn_global_load_lds((const unsigned*)(_s + 128 + DF_KOFF), _d + 2048, 16, 0, 0); } while (0)
#define DF_DMAV(t) do { const char* _s = vsrc + (size_t)(t) * (64 * INW * 2); ALAS unsigned* _d = (ALAS unsigned*)(lds + VOFF + ((t) & 1) * VBB + w * 1024); \
        __builtin_amdgcn_global_load_lds((const unsigned*)(_s + DF_VOFF), _d, 16, 0, 0); __builtin_amdgcn_global_load_lds((const unsigned*)(_s + 128 + DF_VOFF), _d + 2048, 16, 0, 0); } while (0)
    ALAS float* scr = (ALAS float*)(lds + SCR_OFF + w * 256);
    float m = 0.f, l = 0.f;
    f32x16 negm = f32x16{};
    f32x16 o[NDB];
#pragma unroll
    for (int d = 0; d < NDB; ++d) o[d] = f32x16{};
    const int kfrag = comp * 8192 + hi * 1024 + r32 * 16;
    const int vfrag = VOFF + ((lane >> 4) & 1) * 32 + (lane & 3) * 8 + (4 * hi + ((lane & 15) >> 2)) * 64;
#define DF_SBAR() __builtin_amdgcn_sched_barrier(0)
#define DF_QK1(S0, S1, t, d0) do { const ALAS unsigned char* _kb = lds + ((t) & 1) * KBB + kfrag + (d0) * 2048; const bf16x8 _k0 = *(const ALAS bf16x8*)(_kb), _k1 = *(const ALAS bf16x8*)(_kb + 512); \
        S0 = __builtin_amdgcn_mfma_f32_32x32x16_bf16(_k0, qf[d0], (d0) == 0 ? negm : S0, 0, 0, 0); S1 = __builtin_amdgcn_mfma_f32_32x32x16_bf16(_k1, qf[d0], (d0) == 0 ? negm : S1, 0, 0, 0); } while (0)
#define DF_PV1(PW, t, d) do { const ALAS unsigned char* _vb = lds + ((t) & 1) * VBB + vfrag + (d) * 4096; \
        _Pragma("unroll") for (int ks = 0; ks < 4; ++ks) { const s16x4 _lo = vtr(_vb + ks * 1024), _hi = vtr(_vb + ks * 1024 + 512); \
            const bf16x8 _vf = (bf16x8){_lo[0], _lo[1], _lo[2], _lo[3], _hi[0], _hi[1], _hi[2], _hi[3]}; \
            o[d] = __builtin_amdgcn_mfma_f32_32x32x16_bf16(__builtin_bit_cast(bf16x8, PW[ks]), _vf, o[d], 0, 0, 0); } } while (0)
#define DF_SM1(C0, C1, PW, i) do { C0[2 * (i)] = __builtin_amdgcn_exp2f(C0[2 * (i)]); C0[2 * (i) + 1] = __builtin_amdgcn_exp2f(C0[2 * (i) + 1]); \
        C1[2 * (i)] = __builtin_amdgcn_exp2f(C1[2 * (i)]); C1[2 * (i) + 1] = __builtin_amdgcn_exp2f(C1[2 * (i) + 1]); \
        lsum = aadd(lsum, aadd(aadd_t(C0[2 * (i)], C0[2 * (i) + 1]), aadd_t(C1[2 * (i)], C1[2 * (i) + 1]))); \
        PW[(i) >> 2][(i) & 3] = cvtpk(C0[2 * (i)], C0[2 * (i) + 1]); PW[2 + ((i) >> 2)][(i) & 3] = cvtpk(C1[2 * (i)], C1[2 * (i) + 1]); } while (0)
#define DF_QK(S0, S1, t) do { DF_SBAR(); DF_QK1(S0, S1, t, 0); DF_SBAR(); DF_QK1(S0, S1, t, 1); DF_SBAR(); DF_QK1(S0, S1, t, 2); DF_SBAR(); DF_QK1(S0, S1, t, 3); DF_SBAR(); } while (0)
#define DF_PV(PW, t) do { DF_SBAR(); DF_PV1(PW, t, 0); DF_SBAR(); DF_PV1(PW, t, 1); DF_SBAR(); DF_PV1(PW, t, 2); DF_SBAR(); DF_PV1(PW, t, 3); DF_SBAR(); } while (0)
#define DF_MAX(C0, C1, mx) do { mx = fmaxf(C0[0], C1[0]); _Pragma("unroll") for (int r = 1; r < 16; ++r) mx = fmaxf(mx, fmaxf(C0[r], C1[r])); mx = xhalf_max(mx); } while (0)
#define DF_RESCALE(C0, C1, dl) do { const float _dl = (dl), _al = __builtin_amdgcn_exp2f(-_dl); m += _dl; l *= _al; scr[r32] = _al; \
        _Pragma("unroll") for (int r = 0; r < 16; ++r) { const float _a = scr[4 * hi + CROWC(r)]; _Pragma("unroll") for (int d = 0; d < NDB; ++d) o[d][r] *= _a; } \
        _Pragma("unroll") for (int r = 0; r < 16; ++r) { C0[r] -= _dl; C1[r] -= _dl; negm[r] = -m; } } while (0)
#define DF_SOFTMAX(C0, C1, PW) do { float _ls = 0.f; \
        _Pragma("unroll") for (int r = 0; r < 16; ++r) { C0[r] = __builtin_amdgcn_exp2f(C0[r]); C1[r] = __builtin_amdgcn_exp2f(C1[r]); _ls += C0[r] + C1[r]; } \
        l += _ls; \
        _Pragma("unroll") for (int s = 0; s < 2; ++s) { \
            PW[s]     = (u32x4){cvtpk(C0[8 * s], C0[8 * s + 1]), cvtpk(C0[8 * s + 2], C0[8 * s + 3]), cvtpk(C0[8 * s + 4], C0[8 * s + 5]), cvtpk(C0[8 * s + 6], C0[8 * s + 7])}; \
            PW[2 + s] = (u32x4){cvtpk(C1[8 * s], C1[8 * s + 1]), cvtpk(C1[8 * s + 2], C1[8 * s + 3]), cvtpk(C1[8 * s + 4], C1[8 * s + 5]), cvtpk(C1[8 * s + 6], C1[8 * s + 7])}; } } while (0)
#define DF_KLD(F, t, d0) do { const ALAS unsigned char* _kb = lds + ((t) & 1) * KBB + kfrag + (d0) * 2048; F[0] = *(const ALAS bf16x8*)(_kb); F[1] = *(const ALAS bf16x8*)(_kb + 512); } while (0)
#define DF_VLD(F, t, d, kp) do { const ALAS unsigned char* _vb = lds + ((t) & 1) * VBB + vfrag + (d) * 4096 + (kp) * 2048; \
        _Pragma("unroll") for (int k2 = 0; k2 < 2; ++k2) { const s16x4 _lo = vtr(_vb + k2 * 1024), _hi = vtr(_vb + k2 * 1024 + 512); F[k2] = (bf16x8){_lo[0], _lo[1], _lo[2], _lo[3], _hi[0], _hi[1], _hi[2], _hi[3]}; } } while (0)
#define DF_QKM(S0, S1, F, d0) do { S0 = __builtin_amdgcn_mfma_f32_32x32x16_bf16(F[0], qf[d0], (d0) == 0 ? negm : S0, 0, 0, 0); S1 = __builtin_amdgcn_mfma_f32_32x32x16_bf16(F[1], qf[d0], (d0) == 0 ? negm : S1, 0, 0, 0); } while (0)
#define DF_PVM(PW, F, d, kp) do { o[d] = __builtin_amdgcn_mfma_f32_32x32x16_bf16(__builtin_bit_cast(bf16x8, PW[2 * (kp)]), F[0], o[d], 0, 0, 0); \
        o[d] = __builtin_amdgcn_mfma_f32_32x32x16_bf16(__builtin_bit_cast(bf16x8, PW[2 * (kp) + 1]), F[1], o[d], 0, 0, 0); } while (0)
#define DF_MAX8(mx, S, b0) amax3(amax3(amax3(amax3(mx, S[b0], S[b0 + 1]), S[b0 + 2], S[b0 + 3]), S[b0 + 4], S[b0 + 5]), S[b0 + 6], S[b0 + 7])
#define DF_MAX6(mx, S, b0) amax3(amax3(amax3(mx, S[b0], S[b0 + 1]), S[b0 + 2], S[b0 + 3]), S[b0 + 4], S[b0 + 5])
#define DF_STEP_FAST(C0, C1, N0, N1, PWO, PWN, t) do { \
        DF_DMAK((t) + 2); DF_DMAV(t); \
        bf16x8 fa[2], fb[2]; \
        DF_KLD(fa, (t) + 1, 0); \
        if (__any(mxc > THR)) { DF_PV(PWO, (t) - 1); PWO[0] = (u32x4){0u, 0u, 0u, 0u}; PWO[1] = PWO[0]; PWO[2] = PWO[0]; PWO[3] = PWO[0]; DF_RESCALE(C0, C1, fmaxf(mxc, 0.f)); } \
        float lsum = 0.f, mxa; DF_SBAR(); \
        DF_KLD(fb, (t) + 1, 1); DF_QKM(N0, N1, fa, 0); DF_SM1(C0, C1, PWN, 0); asm volatile("" :: "v"(N0[0]), "v"(N1[0])); DF_SBAR(); \
        DF_KLD(fa, (t) + 1, 2); DF_QKM(N0, N1, fb, 1); DF_SM1(C0, C1, PWN, 1); asm volatile("" :: "v"(N0[0]), "v"(N1[0])); DF_SBAR(); \
        DF_KLD(fb, (t) + 1, 3); DF_QKM(N0, N1, fa, 2); DF_SM1(C0, C1, PWN, 2); asm volatile("" :: "v"(N0[0]), "v"(N1[0])); DF_SBAR(); \
        DF_VLD(fa, (t) - 1, 0, 0); DF_QKM(N0, N1, fb, 3); DF_SM1(C0, C1, PWN, 3); asm volatile("" :: "v"(N0[0]), "v"(N1[0])); DF_SBAR(); \
        DF_VLD(fb, (t) - 1, 0, 1); DF_PVM(PWO, fa, 0, 0); DF_SM1(C0, C1, PWN, 4); asm volatile("" :: "v"(o[0][0])); DF_SBAR(); \
        DF_VLD(fa, (t) - 1, 1, 0); DF_PVM(PWO, fb, 0, 1); DF_SM1(C0, C1, PWN, 5); asm volatile("" :: "v"(o[0][0])); DF_SBAR(); \
        DF_VLD(fb, (t) - 1, 1, 1); DF_PVM(PWO, fa, 1, 0); DF_SM1(C0, C1, PWN, 6); asm volatile("" :: "v"(o[1][0])); DF_SBAR(); \
        DF_VLD(fa, (t) - 1, 2, 0); DF_PVM(PWO, fb, 1, 1); DF_SM1(C0, C1, PWN, 7); asm volatile("" :: "v"(o[1][0])); DF_SBAR(); \
        asm volatile("" :: "v"(N0[0]), "v"(N1[0]));     \
        DF_VLD(fb, (t) - 1, 2, 1); DF_PVM(PWO, fa, 2, 0); mxa = DF_MAX6(__builtin_amdgcn_fmed3f(N0[0], N0[1], __builtin_inff()), N0, 2); asm volatile("" :: "v"(o[2][0])); DF_SBAR(); \
        DF_VLD(fa, (t) - 1, 3, 0); DF_PVM(PWO, fb, 2, 1); mxa = DF_MAX6(amax2(mxa, __builtin_amdgcn_fmed3f(N1[0], N1[1], __builtin_inff())), N1, 2); asm volatile("" :: "v"(o[2][0])); DF_SBAR(); \
        DF_VLD(fb, (t) - 1, 3, 1); DF_PVM(PWO, fa, 3, 0); mxa = DF_MAX8(mxa, N0, 8); asm volatile("" :: "v"(o[3][0])); DF_SBAR(); \
        DF_PVM(PWO, fb, 3, 1); mxa = DF_MAX8(mxa, N1, 8); mxc = xhalf_max(mxa); asm volatile("" :: "v"(o[3][0])); DF_SBAR(); \
        l += lsum; \
        __syncthreads(); } while (0)
#define DF_STEP_GEN(C0, C1, N0, N1, PWO, PWN, t) do { \
        if ((t) + 2 < t1) DF_DMAK((t) + 2); \
        DF_DMAV(t); \
        const int _kv0 = (t) * 64; const bool _act = _kv0 <= q0 + 31, _actn = ((t) + 1 < t1) && (_kv0 + 64 <= q0 + 31); \
        if (_act) { \
            if (_kv0 + 63 > q0) { const int _qr = q0 + r32 - _kv0 - 4 * hi; _Pragma("unroll") for (int r = 0; r < 16; ++r) { if (CROWC(r) > _qr) C0[r] = -INFINITY; if (CROWC(r) + 32 > _qr) C1[r] = -INFINITY; } } \
            float _mx; DF_MAX(C0, C1, _mx); \
            if ((t) == 0) { m = _mx; _Pragma("unroll") for (int r = 0; r < 16; ++r) { C0[r] -= _mx; C1[r] -= _mx; negm[r] = -_mx; } }     \
            else if (__any(_mx > THR)) { if (pend) { DF_PV(PWO, (t) - 1); pend = false; } DF_RESCALE(C0, C1, fmaxf(_mx, 0.f)); } } \
        if (_actn) { DF_QK(N0, N1, (t) + 1); DF_MAX(N0, N1, mxc); } \
        if (pend) DF_PV(PWO, (t) - 1); \
        pend = false; \
        if (_act) { DF_SOFTMAX(C0, C1, PWN); pend = true; } \
        __syncthreads(); } while (0)

    f32x16 sa0, sa1, sb0, sb1; u32x4 pa[4], pb[4];
    bool pend = false; float mxc = 0.f;
    DF_DMAK(0); DF_DMAK(1);
    __syncthreads();
    DF_QK(sa0, sa1, 0);
    DF_STEP_GEN(sa0, sa1, sb0, sb1, pb, pa, 0);
    DF_STEP_GEN(sb0, sb1, sa0, sa1, pa, pb, 1);
    int t = 2;
    for (; t + 2 < t1; t += 2) {
        DF_STEP_FAST(sa0, sa1, sb0, sb1, pb, pa, t);
        DF_STEP_FAST(sb0, sb1, sa0, sa1, pa, pb, t + 1);
    }
    if (t < t1) {
        DF_STEP_GEN(sa0, sa1, sb0, sb1, pb, pa, t);
        DF_STEP_GEN(sb0, sb1, sa0, sa1, pa, pb, t + 1);
    }
    if (pend) DF_PV(pb, t1 - 1);
#undef DF_DMAK
#undef DF_KOFF
#undef DF_VOFF
#undef DF_KLD
#undef DF_VLD
#undef DF_QKM
#undef DF_PVM
#undef DF_MAX8
#undef DF_MAX6
#undef DF_DMAV
#undef DF_SBAR
#undef DF_QK1
#undef DF_PV1
#undef DF_SM1
#undef DF_QK
#undef DF_PV
#undef DF_MAX
#undef DF_RESCALE
#undef DF_SOFTMAX
#undef DF_STEP_FAST
#undef DF_STEP_GEN
    l = xhalf_sum(l);
    scr[32 + r32] = l;
    float inv[16];
#pragma unroll
    for (int r = 0; r < 16; ++r) inv[r] = 1.0f / scr[32 + 4 * hi + CROWC(r)];
    const size_t orow0 = rowbase + q0;
    __syncthreads();
    ALAS float* ex = (ALAS float*)(lds + (w & 3) * 16384);
    if (w >= 4) {
#pragma unroll
        for (int d = 0; d < NDB; ++d)
#pragma unroll
            for (int r = 0; r < 16; ++r) ex[(d * 16 + r) * 64 + lane] = o[d][r] * inv[r];
    }
    __syncthreads();
    if (w < 4) {
        ALAS unsigned char* stg = lds + 69632 + w * 8192;
        float sw[NDB];
#pragma unroll
        for (int d = 0; d < NDB; ++d) sw[d] = subln_w[d * 32 + r32] * ((1.0f - LAMBDA_INIT) * 16.0f);
#pragma unroll
        for (int r = 0; r < 16; ++r) {
            float v[NDB]; float ss = 0.f;
#pragma unroll
            for (int d = 0; d < NDB; ++d) { v[d] = o[d][r] * inv[r] - lam * ex[(d * 16 + r) * 64 + lane]; ss += v[d] * v[d]; }
            ss += swz_xor<1>(ss); ss += swz_xor<2>(ss); ss += swz_xor<4>(ss); ss += swz_xor<8>(ss); ss += swz_xor<16>(ss);
            const float rn = rsqrtf(ss * (1.0f / 128.0f) + EPS);
#pragma unroll
            for (int d = 0; d < NDB; ++d) *(ALAS unsigned char*)(stg + (4 * hi + CROWC(r)) * 128 + d * 32 + r32) = (unsigned char)__builtin_amdgcn_cvt_pk_fp8_f32(__builtin_amdgcn_fmed3f(v[d] * rn * sw[d], -448.0f, 448.0f), 0.f, 0, false);
        }
        unsigned char* ob = (unsigned char*)ocat + orow0 * DM + hh * 128;
#pragma unroll
        for (int i = 0; i < 4; ++i) { const int idx = i * 64 + lane, row = idx >> 3, ch = idx & 7;
            *(u32x4*)(ob + (size_t)row * DM + ch * 16) = *(const ALAS u32x4*)(stg + row * 128 + ch * 16); }
    }
    __syncthreads();
}
}

namespace att {
constexpr int CR_SCR = 131072 + 14336;
template <class Sched>
__device__ __forceinline__ void cross_phase(ALAS unsigned char* lds, const bf16_t* __restrict__ qc, const bf16_t* __restrict__ kvc, unsigned char* __restrict__ oc, int ocp, const Sched& S) {
    const int tid = fresh_tid(), w = __builtin_amdgcn_readfirstlane(tid >> 6);
    int lane = tid & 63;
    int r32 = lane & 31, hi = lane >> 5;
    unsigned koff = (unsigned)lane * (2112u * 2u), voff = (unsigned)(lane >> 2) * (2112u * 2u) + (unsigned)(lane & 3) * 16u;
    ALAS float* scr = (ALAS float*)(lds + CR_SCR + w * 256);
    pg8::Unit u, un;
    if (!S.next(0, u)) return;
#define CR_KSRC(uu) ((const char*)(kvc + (size_t)((uu).pm >> 4) * MEML * 2112 + (uu).pn * 256 + w * 8))
#define CR_VSRC(uu) ((const char*)(kvc + ((size_t)((uu).pm >> 4) * MEML + (w & 3) * 16) * 2112 + 1024 + (uu).pn * 256 + (w >> 2) * 32))
#define CR_QP(uu) (qc + ((size_t)(uu).pm * 256 + w * 32 + r32) * DM + (uu).pn * 256 + 8 * hi)
#define CR_DMAK(uu, dc, bo) do { const char* _s = CR_KSRC(uu) + (dc) * 128; _Pragma("unroll") for (int _i = 0; _i < 4; ++_i) \
        __builtin_amdgcn_global_load_lds((const unsigned*)(_s + (size_t)_i * (64 * 2112 * 2) + koff), (ALAS unsigned*)(lds + (bo) + (w * 256 + _i * 64) * 16), 16, 0, 0); } while (0)
#define CR_DMAV(uu, kc, bo) do { const char* _s = CR_VSRC(uu) + (size_t)(kc) * (64 * 2112 * 2); _Pragma("unroll") for (int _i = 0; _i < 4; ++_i) \
        __builtin_amdgcn_global_load_lds((const unsigned*)(_s + _i * 128 + voff), (ALAS unsigned*)(lds + (bo) + (w + 8 * _i) * 1024), 16, 0, 0); } while (0)
#define CR_SBAR() __builtin_amdgcn_sched_barrier(0)
#define CR_ENDSTAGE(iss) do { if (iss) asm volatile("s_waitcnt vmcnt(4) lgkmcnt(0)" ::: "memory"); else asm volatile("s_waitcnt vmcnt(0) lgkmcnt(0)" ::: "memory"); \
        __builtin_amdgcn_s_barrier(); asm volatile("" ::: "memory"); { const int _t = bA; bA = bB; bB = bC; bC = _t; } } while (0)
    int bA = 0, bB = 32768, bC = 65536;
    ALAS unsigned char* stg = lds + 98304 + w * 4096;
    bf16x8 qf[4], qn[4];
    { const bf16_t* qp = CR_QP(u);
#pragma unroll
      for (int d0 = 0; d0 < 4; ++d0) qf[d0] = *(const bf16x8*)(qp + 16 * d0); }
    CR_DMAK(u, 0, bA); CR_DMAK(u, 1, bB);
    asm volatile("s_waitcnt vmcnt(4)" ::: "memory"); __builtin_amdgcn_s_barrier(); asm volatile("" ::: "memory");
#pragma unroll 1
    for (int ui = 0;; ++ui) {
        const bool has_next = S.next(ui + 1, un);
        asm volatile("" : "+v"(lane));
        r32 = lane & 31; hi = lane >> 5; koff = (unsigned)lane * (2112u * 2u); voff = (unsigned)(lane >> 2) * (2112u * 2u) + (unsigned)(lane & 3) * 16u;
        const int vfrag = ((lane >> 4) & 1) * 32 + (lane & 3) * 8 + (4 * hi + ((lane & 15) >> 2)) * 64;
        const bf16_t* qp = CR_QP(u);
        f32x16 s[8];
#pragma unroll
        for (int kb = 0; kb < 8; ++kb) s[kb] = f32x16{};
#pragma unroll
        for (int dc = 0; dc < 4; ++dc) {
            if (dc < 3) {
#pragma unroll
                for (int d0 = 0; d0 < 4; ++d0) qn[d0] = *(const bf16x8*)(qp + (dc + 1) * 64 + 16 * d0);
            }
            if (dc < 2) CR_DMAK(u, dc + 2, bC); else CR_DMAV(u, dc - 2, bC);
            const ALAS unsigned char* kbase = lds + bA + (hi * 256 + r32) * 16;
            bf16x8 fa[2], fb[2];
#define CR_KLD(F, g) do { _Pragma("unroll") for (int k2 = 0; k2 < 2; ++k2) F[k2] = *(const ALAS bf16x8*)(kbase + (2 * (2 * ((g) & 1) + k2) * 256 + ((g) >> 1) * 32) * 16); } while (0)
#define CR_KMM(F, g) do { _Pragma("unroll") for (int k2 = 0; k2 < 2; ++k2) s[(g) >> 1] = __builtin_amdgcn_mfma_f32_32x32x16_bf16(F[k2], qf[2 * ((g) & 1) + k2], s[(g) >> 1], 0, 0, 0); } while (0)
            CR_KLD(fa, 0); CR_SBAR();
            CR_KLD(fb, 1); CR_KMM(fa, 0); CR_SBAR();
            CR_KLD(fa, 2); CR_KMM(fb, 1); CR_SBAR();
            CR_KLD(fb, 3); CR_KMM(fa, 2); CR_SBAR();
            CR_KLD(fa, 4); CR_KMM(fb, 3); CR_SBAR();
            CR_KLD(fb, 5); CR_KMM(fa, 4); CR_SBAR();
            CR_KLD(fa, 6); CR_KMM(fb, 5); CR_SBAR();
            CR_KLD(fb, 7); CR_KMM(fa, 6); CR_SBAR();
            CR_KLD(fa, 8); CR_KMM(fb, 7); CR_SBAR();
            CR_KLD(fb, 9); CR_KMM(fa, 8); CR_SBAR();
            CR_KLD(fa, 10); CR_KMM(fb, 9); CR_SBAR();
            CR_KLD(fb, 11); CR_KMM(fa, 10); CR_SBAR();
            CR_KLD(fa, 12); CR_KMM(fb, 11); CR_SBAR();
            CR_KLD(fb, 13); CR_KMM(fa, 12); CR_SBAR();
            CR_KLD(fa, 14); CR_KMM(fb, 13); CR_SBAR();
            CR_KLD(fb, 15); CR_KMM(fa, 14); CR_SBAR();
            CR_KMM(fb, 15); CR_SBAR();
#undef CR_KLD
#undef CR_KMM
            if (dc < 3) {
#pragma unroll
                for (int d0 = 0; d0 < 4; ++d0) qf[d0] = qn[d0];
            }
            CR_ENDSTAGE(true);
        }
        float mx = s[0][0];
#pragma unroll
        for (int kb = 0; kb < 8; ++kb)
#pragma unroll
            for (int r = 0; r < 16; ++r) mx = fmaxf(mx, s[kb][r]);
        mx = fmaxf(mx, __shfl_xor(mx, 32));
        float l = 0.f;
        u32x4 pw[16];
#pragma unroll
        for (int kb = 0; kb < 8; ++kb) {
#pragma unroll
            for (int r = 0; r < 16; ++r) { s[kb][r] = __builtin_amdgcn_exp2f(s[kb][r] - mx); l += s[kb][r]; }
#pragma unroll
            for (int s2 = 0; s2 < 2; ++s2)
                pw[kb * 2 + s2] = (u32x4){cvtpk(s[kb][8 * s2], s[kb][8 * s2 + 1]), cvtpk(s[kb][8 * s2 + 2], s[kb][8 * s2 + 3]), cvtpk(s[kb][8 * s2 + 4], s[kb][8 * s2 + 5]), cvtpk(s[kb][8 * s2 + 6], s[kb][8 * s2 + 7])};
        }
        l += __shfl_xor(l, 32);
        scr[r32] = l;
#pragma unroll
        for (int dh = 0; dh < 2; ++dh) {
            f32x16 o[4];
#pragma unroll
            for (int d = 0; d < 4; ++d) o[d] = f32x16{};
#pragma unroll
            for (int kc = 0; kc < 4; ++kc) {
                const int st = 4 + dh * 4 + kc;
                bool issued = true;
                if (st + 2 < 8) CR_DMAV(u, st + 2 - 4, bC); else if (st + 2 < 12) CR_DMAV(u, st + 2 - 8, bC); else if (has_next) CR_DMAK(un, st + 2 - 12, bC); else issued = false;
                const ALAS unsigned char* vb = lds + bA + vfrag + dh * 16384;
                bf16x8 fa[2], fb[2];
#define CR_VLD(F, g) do { _Pragma("unroll") for (int k2 = 0; k2 < 2; ++k2) { const s16x4 _lo = vtr(vb + ((g) >> 1) * 4096 + ((g) & 1) * 2048 + k2 * 1024), _hi = vtr(vb + ((g) >> 1) * 4096 + ((g) & 1) * 2048 + k2 * 1024 + 512); \
                F[k2] = (bf16x8){_lo[0], _lo[1], _lo[2], _lo[3], _hi[0], _hi[1], _hi[2], _hi[3]}; } } while (0)
#define CR_VMM(F, g) do { _Pragma("unroll") for (int k2 = 0; k2 < 2; ++k2) \
                o[(g) >> 1] = __builtin_amdgcn_mfma_f32_32x32x16_bf16(__builtin_bit_cast(bf16x8, pw[(2 * kc + ((g) & 1)) * 2 + k2]), F[k2], o[(g) >> 1], 0, 0, 0); } while (0)
                CR_VLD(fa, 0); CR_SBAR();
                CR_VLD(fb, 1); CR_VMM(fa, 0); CR_SBAR();
                CR_VLD(fa, 2); CR_VMM(fb, 1); CR_SBAR();
                CR_VLD(fb, 3); CR_VMM(fa, 2); CR_SBAR();
                CR_VLD(fa, 4); CR_VMM(fb, 3); CR_SBAR();
                CR_VLD(fb, 5); CR_VMM(fa, 4); CR_SBAR();
                CR_VLD(fa, 6); CR_VMM(fb, 5); CR_SBAR();
                CR_VLD(fb, 7); CR_VMM(fa, 6); CR_SBAR();
                CR_VMM(fb, 7); CR_SBAR();
#undef CR_VLD
#undef CR_VMM
                CR_ENDSTAGE(issued);
            }
            if (dh == 1 && has_next) { const bf16_t* qpn = CR_QP(un);
#pragma unroll
                for (int d0 = 0; d0 < 4; ++d0) qn[d0] = *(const bf16x8*)(qpn + 16 * d0); }
            float inv[16];
#pragma unroll
            for (int r = 0; r < 16; ++r) inv[r] = 16.0f / scr[4 * hi + CROWC(r)];
#pragma unroll
            for (int r = 0; r < 16; ++r)
#pragma unroll
                for (int d = 0; d < 4; ++d) *(ALAS unsigned char*)(stg + (4 * hi + CROWC(r)) * 128 + d * 32 + r32) = (unsigned char)__builtin_amdgcn_cvt_pk_fp8_f32(__builtin_amdgcn_fmed3f(o[d][r] * inv[r], -448.0f, 448.0f), 0.f, 0, false);
            unsigned char* ob = oc + ((size_t)u.pm * 256 + w * 32) * ocp + u.pn * 256 + dh * 128;
#pragma unroll
            for (int i = 0; i < 4; ++i) { const int idx = i * 64 + lane, row = idx >> 3, ch = idx & 7;
                *(u32x4*)(ob + (size_t)row * ocp + ch * 16) = *(const ALAS u32x4*)(stg + row * 128 + ch * 16); }
        }
        if (!has_next) break;
        u = un;
#pragma unroll
        for (int d0 = 0; d0 < 4; ++d0) qf[d0] = qn[d0];
    }
#undef CR_KSRC
#undef CR_VSRC
#undef CR_QP
#undef CR_DMAK
#undef CR_DMAV
#undef CR_SBAR
#undef CR_ENDSTAGE
}
}


namespace att {
template <class F>
__device__ __forceinline__ void swa_phase(ALAS unsigned char* lds, const bf16_t* __restrict__ projr, bf16_t* __restrict__ ocat, const float* __restrict__ sinks, int first, int stride, int count, F unit_of) {
    const int tid = fresh_tid(), w = __builtin_amdgcn_readfirstlane(tid >> 6);
    int lane = tid & 63;
    const int g = w >> 1, qsub = w & 1;
    ALAS float* scr = (ALAS float*)(lds + CR_SCR + w * 256);
    ALAS unsigned char* stg = lds + 98304 + w * 4096;
    if (first >= count) return;
    int ub, uh, uj; unit_of(first, ub, uh, uj);
#define SW_T0(j) ((j) >= 2 ? (j) - 2 : 0)
#define SW_DMA(b_, h_, j_, bo) do { const char* _ks = (const char*)(projr + (size_t)(b_) * SEQ * INW + SK0 + (h_) * 64 + w * 8); \
        const char* _vs = (const char*)(projr + ((size_t)(b_) * SEQ + (w & 3) * 16) * INW + SV0 + (h_) * 64 + (w >> 2) * 32); \
        const unsigned _ko = (unsigned)lane * (INW * 2), _vo = (unsigned)(lane >> 2) * (INW * 2) + (unsigned)(lane & 3) * 16; \
        for (int _t = SW_T0(j_); _t <= (j_); ++_t) { const int _sl = _t - SW_T0(j_); \
            __builtin_amdgcn_global_load_lds((const unsigned*)(_ks + (size_t)_t * (64 * INW * 2) + _ko), (ALAS unsigned*)(lds + (bo) + _sl * 8192 + w * 1024), 16, 0, 0); \
            __builtin_amdgcn_global_load_lds((const unsigned*)(_vs + (size_t)_t * (64 * INW * 2) + _vo), (ALAS unsigned*)(lds + (bo) + 24576 + _sl * 8192 + w * 1024), 16, 0, 0); } } while (0)
#define SW_QLD(Q, b_, h_, j_) do { const bf16_t* _qp = projr + ((size_t)(b_) * SEQ + (j_) * 64 + qsub * 32 + (lane & 31)) * INW + SQ0 + ((h_) * 4 + g) * 64 + 8 * (lane >> 5); \
        _Pragma("unroll") for (int d0 = 0; d0 < 4; ++d0) Q[d0] = *(const bf16x8*)(_qp + 16 * d0); } while (0)
    bf16x8 qf[4], qn[4];
    SW_QLD(qf, ub, uh, uj);
    SW_DMA(ub, uh, uj, 0);
    int bo = 0;
#pragma unroll 1
    for (int L = first; L < count; L += stride) {
        const bool has_next = L + stride < count;
        int nb = 0, nh = 0, nj = 0, nnt = 0;
        asm volatile("" : "+v"(lane));
        if (has_next) { unit_of(L + stride, nb, nh, nj); nnt = nj - SW_T0(nj) + 1; SW_QLD(qn, nb, nh, nj); SW_DMA(nb, nh, nj, 49152 - bo); }
        if (nnt == 3) asm volatile("s_waitcnt vmcnt(6)" ::: "memory"); else if (nnt == 2) asm volatile("s_waitcnt vmcnt(4)" ::: "memory"); else if (nnt == 1) asm volatile("s_waitcnt vmcnt(2)" ::: "memory"); else asm volatile("s_waitcnt vmcnt(0)" ::: "memory");
        __builtin_amdgcn_s_barrier(); asm volatile("" ::: "memory");
        const int r32 = lane & 31, hi = lane >> 5;
        const int q0 = uj * 64 + qsub * 32, t0 = SW_T0(uj);
        float m = sinks[uh * 4 + g] * 1.4426950408889634f, l = hi == 0 ? 1.0f : 0.f;
        f32x16 o[2]; o[0] = f32x16{}; o[1] = f32x16{};
        const int kfrag = hi * 1024 + r32 * 16;
        const int vfrag = 24576 + ((lane >> 4) & 1) * 32 + (lane & 3) * 8 + (4 * hi + ((lane & 15) >> 2)) * 64;
#pragma unroll 1
        for (int t = t0; t <= uj; ++t) {
            const int kv0 = t * 64, sl = t - t0;
            if ((kv0 > q0 + 31) || (q0 - (kv0 + 63) >= 128)) continue;
            const ALAS unsigned char* kb = lds + bo + sl * 8192 + kfrag;
            f32x16 p0 = f32x16{}, p1 = f32x16{};
#pragma unroll
            for (int d0 = 0; d0 < 4; ++d0) {
                const bf16x8 k0 = *(const ALAS bf16x8*)(kb + d0 * 2048), k1 = *(const ALAS bf16x8*)(kb + d0 * 2048 + 512);
                p0 = __builtin_amdgcn_mfma_f32_32x32x16_bf16(k0, qf[d0], p0, 0, 0, 0);
                p1 = __builtin_amdgcn_mfma_f32_32x32x16_bf16(k1, qf[d0], p1, 0, 0, 0);
            }
            if ((kv0 + 63 > q0) || (q0 + 31 - kv0 >= 128)) {
                const int qr = q0 + r32 - kv0 - 4 * hi;
#pragma unroll
                for (int r = 0; r < 16; ++r) {
                    if (CROWC(r) > qr || qr - CROWC(r) >= 128) p0[r] = -INFINITY;
                    if (CROWC(r) + 32 > qr || qr - CROWC(r) - 32 >= 128) p1[r] = -INFINITY;
                }
            }
            float mx = fmaxf(p0[0], p1[0]);
#pragma unroll
            for (int r = 1; r < 16; ++r) mx = fmaxf(mx, fmaxf(p0[r], p1[r]));
            mx = fmaxf(mx, __shfl_xor(mx, 32));
            if (__any(mx > m + THR)) {
                const float mn = fmaxf(m, mx), alpha = __builtin_amdgcn_exp2f(m - mn);
                m = mn; l *= alpha;
                scr[r32] = alpha;
#pragma unroll
                for (int r = 0; r < 16; ++r) { const float a = scr[4 * hi + CROWC(r)]; o[0][r] *= a; o[1][r] *= a; }
            }
            float ls = 0.f;
#pragma unroll
            for (int r = 0; r < 16; ++r) { p0[r] = __builtin_amdgcn_exp2f(p0[r] - m); p1[r] = __builtin_amdgcn_exp2f(p1[r] - m); ls += p0[r] + p1[r]; }
            l += ls;
            u32x4 pw[4];
#pragma unroll
            for (int s = 0; s < 2; ++s) {
                pw[s]     = (u32x4){cvtpk(p0[8 * s], p0[8 * s + 1]), cvtpk(p0[8 * s + 2], p0[8 * s + 3]), cvtpk(p0[8 * s + 4], p0[8 * s + 5]), cvtpk(p0[8 * s + 6], p0[8 * s + 7])};
                pw[2 + s] = (u32x4){cvtpk(p1[8 * s], p1[8 * s + 1]), cvtpk(p1[8 * s + 2], p1[8 * s + 3]), cvtpk(p1[8 * s + 4], p1[8 * s + 5]), cvtpk(p1[8 * s + 6], p1[8 * s + 7])};
            }
            const ALAS unsigned char* vb = lds + bo + sl * 8192 + vfrag;
#pragma unroll
            for (int d = 0; d < 2; ++d)
#pragma unroll
                for (int ks = 0; ks < 4; ++ks) {
                    const s16x4 lo = vtr(vb + d * 4096 + ks * 1024), hi4 = vtr(vb + d * 4096 + ks * 1024 + 512);
                    const bf16x8 vf = (bf16x8){lo[0], lo[1], lo[2], lo[3], hi4[0], hi4[1], hi4[2], hi4[3]};
                    o[d] = __builtin_amdgcn_mfma_f32_32x32x16_bf16(__builtin_bit_cast(bf16x8, pw[ks]), vf, o[d], 0, 0, 0);
                }
        }
        l += __shfl_xor(l, 32);
        scr[32 + r32] = l;
#pragma unroll
        for (int r = 0; r < 16; ++r) { const float inv = 16.0f / scr[32 + 4 * hi + CROWC(r)];
#pragma unroll
            for (int d = 0; d < 2; ++d) *(ALAS unsigned char*)(stg + (4 * hi + CROWC(r)) * 64 + d * 32 + r32) = (unsigned char)__builtin_amdgcn_cvt_pk_fp8_f32(__builtin_amdgcn_fmed3f(o[d][r] * inv, -448.0f, 448.0f), 0.f, 0, false); }
        unsigned char* ob = (unsigned char*)ocat + ((size_t)ub * SEQ + q0) * DM + 512 + (uh * 4 + g) * 64;
#pragma unroll
        for (int i = 0; i < 2; ++i) { const int idx = i * 64 + lane, row = idx >> 2, ch = idx & 3;
            *(u32x4*)(ob + (size_t)row * DM + ch * 16) = *(const ALAS u32x4*)(stg + row * 64 + ch * 16); }
        asm volatile("s_waitcnt lgkmcnt(0)" ::: "memory"); __builtin_amdgcn_s_barrier(); asm volatile("" ::: "memory");
        ub = nb; uh = nh; uj = nj; bo = 49152 - bo;
#pragma unroll
        for (int d0 = 0; d0 < 4; ++d0) qf[d0] = qn[d0];
    }
#undef SW_T0
#undef SW_DMA
#undef SW_QLD
}
}

#define LAS __attribute__((address_space(3)))
#define GAS __attribute__((address_space(1)))
constexpr int NWAVES = 8;
constexpr int RING_BYTES = 131072;
constexpr int LX_BAR = RING_BYTES;
constexpr int LX_PST = RING_BYTES + 64;
constexpr int MOE_MAXU = 6;
constexpr int LX_TOK = RING_BYTES + 1024;
constexpr int LX_RST = LX_TOK + MOE_MAXU * 1024;
constexpr int LDS_BYTES = 147456;
static_assert(LX_RST + MOE_MAXU * 1024 <= LDS_BYTES, "LDS map");

constexpr size_t WS_WIN  = WS_END;
constexpr size_t WS_WOUT = WS_WIN + (size_t)(2304 + 2048) * 1024 * 2;
constexpr size_t WS_WQ   = WS_WOUT + (size_t)1024 * 1024 * 2;
constexpr size_t WS_WOC  = WS_WQ + (size_t)1024 * 1024 * 2;
constexpr size_t WS_WGU  = WS_WOC + (size_t)1024 * 1024 * 2;
constexpr size_t WS_WD   = WS_WGU + (size_t)32 * 1024 * 1024 * 2;
constexpr size_t WS_SSP1 = WS_WD + (size_t)32 * 1024 * 512 * 2;
constexpr size_t WS_SSP2 = WS_SSP1 + (size_t)NTOK * 16 * 4;
constexpr size_t WS_WR   = WS_SSP2 + (size_t)NTOK * 16 * 4;
constexpr int KVP = 2112;
constexpr size_t WS_KVC2 = WS_WR + (size_t)2 * 48 * 1024 * 2;
constexpr size_t WS_END2 = WS_KVC2 + (size_t)NMEM * KVP * 2;
static_assert(WS_END2 <= (size_t)512 * 1024 * 1024, "workspace too big");
constexpr int OCP = 4608;
constexpr int CW_DEP8 = 7168;
constexpr int CW_BAR = 16;

#define XB_TMO      128
#define XB_XCNT(j)  (256  + 64 * (j))
#define XB_XSUB(j)  (1280 + 64 * (j))
#define XB_XGEN(j)  (2304 + 64 * (j))
#define XB_TOP      3328
#define XB_TOPGEN   3392
#define XCD_BAR_WORDS 3456
#define XB_LSUB(j)  (3456 + 64 * (j))
#define XB_LGEN(j)  (4480 + 64 * (j))
#define XB_SPIN_CAP (1u << 18)
__device__ __forceinline__ unsigned xb_ld(unsigned* p)              { return __hip_atomic_load(p, __ATOMIC_RELAXED, __HIP_MEMORY_SCOPE_AGENT); }
__device__ __forceinline__ unsigned xb_add(unsigned* p, unsigned v) { return __hip_atomic_fetch_add(p, v, __ATOMIC_RELAXED, __HIP_MEMORY_SCOPE_AGENT); }
__device__ __forceinline__ unsigned xb_xcc_id() { return (unsigned)__builtin_amdgcn_s_getreg((3 << 11) | 20) & 0xFu; }
#define XB_SPIN(cond, bar) do { unsigned _sp = 0; while (cond) { __builtin_amdgcn_s_sleep(1); \
    if ((++_sp & 255u) == 0u) { if (xb_ld(&(bar)[XB_TMO])) break; if (_sp > XB_SPIN_CAP) { atomicAdd(&(bar)[XB_TMO], 1u); break; } } } } while (0)
struct XcdBarrier { unsigned* bar; unsigned x; volatile LAS unsigned* st; };
__device__ __forceinline__ XcdBarrier xcd_barrier_post(unsigned* bar, volatile LAS unsigned* st) {
    XcdBarrier b; b.bar = bar; b.x = xb_xcc_id(); b.st = st;
    if (threadIdx.x == 0) st[2] = xb_add(&bar[XB_XCNT(b.x)], 1u);
    return b;
}
__device__ __forceinline__ void xcd_barrier_complete(unsigned* bar, unsigned x, unsigned& nloc, unsigned& nx) {
    const unsigned G = gridDim.x * gridDim.y * gridDim.z;
    unsigned sum, cnt, mine, sp = 0u;
    for (;;) {
        sum = 0u; cnt = 0u; mine = 0u;
#pragma unroll
        for (unsigned j = 0; j < 16; ++j) { const unsigned c = xb_ld(&bar[XB_XCNT(j)]); sum += c; cnt += (c > 0u) ? 1u : 0u; mine = (j == x) ? c : mine; }
        if (sum == G) break;
        __builtin_amdgcn_s_sleep(1);
        if ((++sp & 255u) == 0u) { if (xb_ld(&bar[XB_TMO])) break; if (sp > XB_SPIN_CAP) { atomicAdd(&bar[XB_TMO], 1u); break; } }
    }
    nloc = mine > 0u ? mine : 1u; nx = cnt > 0u ? cnt : 1u;
}
__device__ __forceinline__ void xcd_barrier(const XcdBarrier& b) {
    asm volatile("s_waitcnt vmcnt(0)" ::: "memory");
    __syncthreads();
    if (threadIdx.x == 0) {
        unsigned* bar = b.bar;
        __builtin_amdgcn_s_waitcnt(0);
        unsigned nloc = b.st[0], nx = b.st[1];
        if (nloc == 0u) { xcd_barrier_complete(bar, b.x, nloc, nx); b.st[0] = nloc; b.st[1] = nx; }
        const unsigned old = xb_add(&bar[XB_XSUB(b.x)], 1u);
        const unsigned gen = old / nloc;
        if (old + 1u == (gen + 1u) * nloc) {
            __builtin_amdgcn_fence(__ATOMIC_RELEASE, "agent");
            asm volatile("s_waitcnt vmcnt(0)" ::: "memory");
            const unsigned og = xb_add(&bar[XB_TOP], 1u);
            const unsigned tg = og / nx;
            if (og + 1u == (tg + 1u) * nx) xb_add(&bar[XB_TOPGEN], 1u);
            else XB_SPIN(xb_ld(&bar[XB_TOPGEN]) == tg, bar);
            __builtin_amdgcn_fence(__ATOMIC_ACQUIRE, "agent");
            xb_add(&bar[XB_XGEN(b.x)], 1u);
            asm volatile("s_waitcnt vmcnt(0)" ::: "memory");
        } else {
            XB_SPIN(xb_ld(&bar[XB_XGEN(b.x)]) == gen, bar);
            __builtin_amdgcn_fence(__ATOMIC_ACQUIRE, "agent");
            asm volatile("s_waitcnt vmcnt(0)" ::: "memory");
        }
    }
    __syncthreads();
}

__device__ __forceinline__ void xcd_local_barrier(const XcdBarrier& b, bool xl) {
    asm volatile("s_waitcnt vmcnt(0)" ::: "memory");
    __syncthreads();
    if (threadIdx.x == 0) {
        unsigned* bar = b.bar;
        __builtin_amdgcn_s_waitcnt(0);
        const unsigned slot = xl ? b.x : 15u, n = xl ? (unsigned)b.st[0] : gridDim.x;
        if (!xl) { __builtin_amdgcn_fence(__ATOMIC_RELEASE, "agent"); asm volatile("s_waitcnt vmcnt(0)" ::: "memory"); }
        const unsigned old = xb_add(&bar[XB_LSUB(slot)], 1u);
        const unsigned gen = old / n;
        if (old + 1u == (gen + 1u) * n) xb_add(&bar[XB_LGEN(slot)], 1u);
        else XB_SPIN(xb_ld(&bar[XB_LGEN(slot)]) == gen, bar);
        __builtin_amdgcn_fence(__ATOMIC_ACQUIRE, "agent");
        asm volatile("s_waitcnt vmcnt(0)" ::: "memory");
    }
    __syncthreads();
}

struct MkArgs {
    const float* in[26];
    float* out; unsigned char* ws;
    int ph_lo, ph_hi, li, pad;
};

__device__ __forceinline__ unsigned pk2rn(float lo, float hi) { return (unsigned)f2bf(lo) | ((unsigned)f2bf(hi) << 16); }
__device__ __forceinline__ int in_rowmap(int n0);
struct P0Item { const float* W; bf16_t* WT; const float* gain; int K, N, dst_row0, k0, n0, rowmap; float q8; };
__device__ __forceinline__ void p0_item_load(const P0Item& it, pg8::f32x4 (&v)[16], int lane) {
    const float* src = it.W + (size_t)(it.k0 + 16 * (lane >> 4)) * it.N + it.n0 + (lane & 15) * 4;
#pragma unroll
    for (int i = 0; i < 16; ++i) v[i] = __builtin_nontemporal_load((const pg8::f32x4*)(src + (size_t)i * it.N));
}
__device__ __forceinline__ void p0_item_store(const P0Item& it, pg8::f32x4 (&v)[16], int lane) {
    const int n4 = (lane & 15) * 4, kq = lane >> 4;
    if (it.gain) {
#pragma unroll
        for (int i = 0; i < 16; ++i) v[i] = v[i] * it.gain[it.k0 + 16 * kq + i];
    }
    const int n = it.n0 + n4;
    int drow;
    if (it.rowmap == 0) drow = it.dst_row0 + n; else if (it.rowmap == 1) drow = in_rowmap(n & ~31) + (n & 31); else drow = it.dst_row0 + 256 * (n >> 7) + (n & 127);
    if (it.q8 != 0.f) {
#pragma unroll
        for (int j = 0; j < 4; ++j) {
            int w[4];
#pragma unroll
            for (int q = 0; q < 4; ++q) { int t = 0; t = __builtin_amdgcn_cvt_pk_fp8_f32(__builtin_amdgcn_fmed3f(v[4 * q][j] * it.q8, -448.0f, 448.0f), __builtin_amdgcn_fmed3f(v[4 * q + 1][j] * it.q8, -448.0f, 448.0f), t, false); t = __builtin_amdgcn_cvt_pk_fp8_f32(__builtin_amdgcn_fmed3f(v[4 * q + 2][j] * it.q8, -448.0f, 448.0f), __builtin_amdgcn_fmed3f(v[4 * q + 3][j] * it.q8, -448.0f, 448.0f), t, true); w[q] = t; }
            pg8::u32x4v o; o.x = (unsigned)w[0]; o.y = (unsigned)w[1]; o.z = (unsigned)w[2]; o.w = (unsigned)w[3];
            __builtin_nontemporal_store(o, (pg8::u32x4v*)((unsigned char*)it.WT + (size_t)(drow + j) * it.K + it.k0 + 16 * kq));
        }
        return;
    }
#pragma unroll
    for (int j = 0; j < 4; ++j) {
        pg8::u32x4v o0, o1;
        o0.x = pk2rn(v[0][j], v[1][j]); o0.y = pk2rn(v[2][j], v[3][j]); o0.z = pk2rn(v[4][j], v[5][j]); o0.w = pk2rn(v[6][j], v[7][j]);
        o1.x = pk2rn(v[8][j], v[9][j]); o1.y = pk2rn(v[10][j], v[11][j]); o1.z = pk2rn(v[12][j], v[13][j]); o1.w = pk2rn(v[14][j], v[15][j]);
        bf16_t* dst = it.WT + (size_t)(drow + j) * it.K + it.k0 + 16 * kq;
        *(pg8::u32x4v*)dst = o0; *(pg8::u32x4v*)(dst + 8) = o1;
    }
}
__device__ __forceinline__ int in_rowmap(int n0) {
    if (n0 < 1024 || (n0 >= 1536 && n0 < 2048)) { const int base = (n0 < 512) ? 0 : (n0 < 1024 ? 512 : 1536), cc = n0 - base; return base + 256 * (cc >> 8) + ((cc >> 5) & 1) * 128 + ((cc >> 6) & 3) * 32; }
    if (n0 < 1536) return n0;
    if (n0 < 2176) { const int cc = n0 - 2048; return 2048 + ((cc >> 5) & 1) * 128 + (cc >> 6) * 32; }
    const int e = n0 - 2176; return 2048 + (e >> 6) * 128 + 64 + (e & 63);
}

struct MoeIt { const float* src; unsigned char* dst; const float* gp; int N, K; float q8; bool gsel; };
__device__ __forceinline__ void moe_decode(MoeIt& m, int r, const float* w_gate, const float* w_up, const float* w_down, const float* ln_moe_w, unsigned char* Wgu8, unsigned char* Wd8, int lane) {
    constexpr int IE = 16 * 8 * 32;
    const int n4 = (lane & 15) * 4, kq = lane >> 4;
    const float* W; unsigned char* db; int k0, n, drow;
    if (r < 2 * IE) { const int up = r >= IE ? 1 : 0; if (up) r -= IE; const int e = r >> 7, q = r & 127, kb = q >> 3, nb = q & 7;
        W = (up ? w_up : w_gate) + (size_t)e * 1024 * 512; m.N = 512; m.K = 1024; k0 = kb * 64; n = nb * 64 + n4; drow = e * 1024 + up * 128 + 256 * (n >> 7) + (n & 127); db = Wgu8; m.q8 = 64.0f; m.gsel = true; }
    else { r -= 2 * IE; const int e = r >> 7, q = r & 127, kb = q >> 4, nb = q & 15;
        W = w_down + (size_t)e * 512 * 1024; m.N = 1024; m.K = 512; k0 = kb * 64; n = nb * 64 + n4; drow = e * 1024 + n; db = Wd8; m.q8 = 32.0f; m.gsel = false; }
    m.src = W + (size_t)(k0 + 16 * kq) * m.N + n;
    m.dst = db + (size_t)drow * m.K + k0 + 16 * kq;
    m.gp = ln_moe_w + k0 + 16 * kq;
}
__device__ __forceinline__ void moe_load(const MoeIt& m, pg8::f32x4 (&g)[4], pg8::f32x4 (&v)[16]) {
#pragma unroll
    for (int c = 0; c < 4; ++c) g[c] = *(const pg8::f32x4*)(m.gp + 4 * c);
#pragma unroll
    for (int i = 0; i < 16; ++i) v[i] = __builtin_nontemporal_load((const pg8::f32x4*)(m.src + (size_t)i * m.N));
}
__device__ __forceinline__ void moe_store(const MoeIt& m, const pg8::f32x4 (&g)[4], const pg8::f32x4 (&v)[16]) {
    float gq[16];
#pragma unroll
    for (int i = 0; i < 16; ++i) gq[i] = m.gsel ? g[i >> 2][i & 3] * m.q8 : m.q8;
#pragma unroll
    for (int j = 0; j < 4; ++j) {
        int w[4];
#pragma unroll
        for (int q = 0; q < 4; ++q) { int t = 0;
            t = __builtin_amdgcn_cvt_pk_fp8_f32(__builtin_amdgcn_fmed3f(v[4 * q][j] * gq[4 * q], -448.0f, 448.0f), __builtin_amdgcn_fmed3f(v[4 * q + 1][j] * gq[4 * q + 1], -448.0f, 448.0f), t, false);
            t = __builtin_amdgcn_cvt_pk_fp8_f32(__builtin_amdgcn_fmed3f(v[4 * q + 2][j] * gq[4 * q + 2], -448.0f, 448.0f), __builtin_amdgcn_fmed3f(v[4 * q + 3][j] * gq[4 * q + 3], -448.0f, 448.0f), t, true); w[q] = t; }
        pg8::u32x4v o; o.x = (unsigned)w[0]; o.y = (unsigned)w[1]; o.z = (unsigned)w[2]; o.w = (unsigned)w[3];
        __builtin_nontemporal_store(o, (pg8::u32x4v*)(m.dst + (size_t)j * m.K));
    }
}

__global__ void __launch_bounds__(NWAVES * 64, 2) mk_fwd(MkArgs args) {
    extern __shared__ __attribute__((aligned(16))) unsigned char lds_raw[];
    LAS unsigned char* lds = (LAS unsigned char*)lds_raw;
    const int tid = threadIdx.x, wave = __builtin_amdgcn_readfirstlane(tid >> 6);
    const int G = gridDim.x; int bx = blockIdx.x;
    int gw = bx * NWAVES + wave; const int NGW = G * NWAVES;
    bool xl = false;
    unsigned char* ws = args.ws;
    unsigned* ctl = (unsigned*)(ws + WS_CTL);
#define KGP(T, v) ((T*)(__attribute__((address_space(1))) T*)(v))
#define KPTRS \
        const __attribute__((address_space(4))) unsigned long long* kp_ = (const __attribute__((address_space(4))) unsigned long long*)__builtin_amdgcn_kernarg_segment_ptr(); \
        asm volatile("" : "+s"(kp_)); \
        unsigned char* ws = KGP(unsigned char, kp_[27]); unsigned* ctl = (unsigned*)(ws + WS_CTL); float* const out_ = KGP(float, kp_[26]); \
        const float* x = KGP(const float, kp_[0]); const float* mem = KGP(const float, kp_[1]); const int* positions = (const int*)KGP(const float, kp_[2]); \
        const float* ln_mix_w = KGP(const float, kp_[3]); const float* w_in = KGP(const float, kp_[4]); \
        const float* w_out = KGP(const float, kp_[11]); const float* ln_cross_w = KGP(const float, kp_[12]); const float* ln_mem_w = KGP(const float, kp_[13]); const float* wq_cross = KGP(const float, kp_[14]); \
        const float* wkv_cross = KGP(const float, kp_[15]); const float* wo_cross = KGP(const float, kp_[16]); const float* ln_moe_w = KGP(const float, kp_[17]); \
        const float* w_group = KGP(const float, kp_[18]); const float* b_group = KGP(const float, kp_[19]); const float* w_expert = KGP(const float, kp_[20]); const float* b_expert = KGP(const float, kp_[21]); \
        const float* w_gate = KGP(const float, kp_[22]); const float* w_up = KGP(const float, kp_[23]); const float* w_down = KGP(const float, kp_[24]); const float* ln_final_w = KGP(const float, kp_[25]); \
        float* rstd0 = (float*)(ws + WS_RSTD0); float* rstdm = (float*)(ws + WS_RSTDM); float* rstd2 = (float*)(ws + WS_RSTD2); \
        float* ropet = (float*)(ws + WS_ROPE); \
        int* tok_e = (int*)(ws + WS_TOKE); int* tok_i = (int*)(ws + WS_TOKI); float* tok_g = (float*)(ws + WS_TOKG); int* explist = (int*)(ws + WS_EXPL); \
        bf16_t* kvc = (bf16_t*)(ws + WS_KVC2); \
        bf16_t* xb = (bf16_t*)(ws + WS_S0); bf16_t* mb = xb + (size_t)NTOK * DM; bf16_t* qc = (bf16_t*)(ws + WS_S0); bf16_t* hdn = (bf16_t*)(ws + WS_S0); \
        bf16_t* projr = (bf16_t*)(ws + WS_S1); bf16_t* oc = (bf16_t*)(ws + WS_S1); bf16_t* y = (bf16_t*)(ws + WS_S1); \
        bf16_t* ocat = (bf16_t*)(ws + WS_S2); bf16_t* h2b = (bf16_t*)(ws + WS_S2); \
        bf16_t* h1b = (bf16_t*)(ws + WS_S3); \
        bf16_t* WinT = (bf16_t*)(ws + WS_WIN); bf16_t* WoutT = (bf16_t*)(ws + WS_WOUT); bf16_t* WqT = (bf16_t*)(ws + WS_WQ); bf16_t* WocT = (bf16_t*)(ws + WS_WOC); \
        unsigned char* Wgu8 = ws + WS_WGU; unsigned char* Wd8 = ws + WS_WD; \
        unsigned char* h2q = ws + WS_WGU + (size_t)32 * 1024 * 1024; \
        unsigned char* hdn8 = ws + WS_S0; \
        unsigned char* y8 = ws + WS_S1; \
        unsigned char* Wq8 = ws + WS_WQ; unsigned char* Woc8 = ws + WS_WOC; \
        unsigned char* oc8 = ws + WS_S1;     \
        unsigned char* h1q = ws + WS_S1 + 2048;     \
        float* ssp1 = (float*)(ws + WS_SSP1); float* ssp2 = (float*)(ws + WS_SSP2); \
        bf16_t* WrT = (bf16_t*)(ws + WS_WR); \
        int* counts = (int*)(ctl + CW_COUNTS);

    for (int u = tid; u < (LDS_BYTES - RING_BYTES) / 4; u += NWAVES * 64) ((LAS unsigned*)(lds + RING_BYTES))[u] = 0u;
    __syncthreads();
    XcdBarrier bar = xcd_barrier_post(ctl + CW_BAR + args.li * XCD_BAR_WORDS, (volatile LAS unsigned*)(lds + LX_BAR));
    const int lo = args.ph_lo, hi = args.ph_hi;
#define IN(k) (lo <= (k) && (k) < hi)
#define SEAM(k) do { if (IN(k) && IN((k) + 1)) xcd_barrier(bar); } while (0)
#define LSEAM(k) do { if (IN(k) && IN((k) + 1)) xcd_local_barrier(bar, xl); } while (0)

    constexpr int I0 = 16 * 36, I1 = 16 * 32, I2 = 16 * 16, IE = 16 * 8 * 32, ID = 8 * 16 * 32;
    constexpr int NMAIN = I0 + I1 + 3 * I2, NMOE = 2 * IE + ID;
#define P0_DECODE_MAIN(IT, idx) do { int r = (idx); \
            if (r < I0) { const int kb = r / 36, nb = r % 36; IT = P0Item{w_in, WinT, ln_mix_w, 1024, 2304, 0, kb * 64, nb * 64, 1, 0.f}; } \
            else if ((r -= I0) < I1) { const int kb = r / 32, nb = r % 32; IT = P0Item{wkv_cross, WinT, ln_mem_w, 1024, 2048, 2304, kb * 64, nb * 64, 0, 0.f}; } \
            else if ((r -= I1) < I2) { const int kb = r / 16, nb = r % 16; IT = P0Item{w_out, WoutT, nullptr, 1024, 1024, 0, kb * 64, nb * 64, 0, 64.0f}; } \
            else if ((r -= I2) < I2) { const int kb = r / 16, nb = r % 16; IT = P0Item{wq_cross, (bf16_t*)Wq8, ln_cross_w, 1024, 1024, 0, kb * 64, nb * 64, 0, 64.0f}; } \
            else { r -= I2; const int kb = r / 16, nb = r % 16; IT = P0Item{wo_cross, (bf16_t*)Woc8, nullptr, 1024, 1024, 0, kb * 64, nb * 64, 0, 64.0f}; } } while (0)
#define P0_DECODE_MOE(IT, idx) do { int r = (idx); \
            if (r < 2 * IE) { const int up = r >= IE ? 1 : 0; if (up) r -= IE; const int e = r >> 7, q = r & 127, kb = q >> 3, nb = q & 7; \
                IT = P0Item{(up ? w_up : w_gate) + (size_t)e * 1024 * 512, (bf16_t*)Wgu8, ln_moe_w, 1024, 512, e * 1024 + up * 128, kb * 64, nb * 64, 2, 64.0f}; } \
            else { r -= 2 * IE; const int e = r >> 7, q = r & 127, kb = q >> 4, nb = q & 15; IT = P0Item{w_down + (size_t)e * 512 * 1024, (bf16_t*)Wd8, nullptr, 512, 1024, e * 1024, kb * 64, nb * 64, 0, 32.0f}; } } while (0)
#define P0_RUN(DEC, first, step, end) do { if ((first) < (end)) { \
            P0Item itc, itn; pg8::f32x4 vc[16], vn[16]; \
            DEC(itc, (first)); p0_item_load(itc, vc, lane); \
            for (int it = (first); it < (end); it += (step)) { \
                const bool has_next = it + (step) < (end); \
                if (has_next) { DEC(itn, it + (step)); p0_item_load(itn, vn, lane); } \
                p0_item_store(itc, vc, lane); \
                if (has_next) { itc = itn; _Pragma("unroll") for (int i = 0; i < 16; ++i) vc[i] = vn[i]; } \
            } } } while (0)
#define MOE_RUN(first, step, end) do { \
            const int cnt_ = (first) < (end) ? ((end) - (first) + (step) - 1) / (step) : 0, npair_ = cnt_ >> 1; \
            if (npair_ > 0) { \
                MoeIt ma, mb; pg8::f32x4 ga[4], gb[4], va[16], vb[16]; int r_ = (first); \
                moe_decode(ma, r_, w_gate, w_up, w_down, ln_moe_w, Wgu8, Wd8, lane); moe_load(ma, ga, va); __builtin_amdgcn_sched_barrier(0); \
                for (int p_ = 0; p_ < npair_ - 1; ++p_) { \
                    moe_decode(mb, r_ + (step), w_gate, w_up, w_down, ln_moe_w, Wgu8, Wd8, lane); moe_load(mb, gb, vb); __builtin_amdgcn_sched_barrier(0); \
                    moe_store(ma, ga, va); \
                    r_ += 2 * (step); \
                    moe_decode(ma, r_, w_gate, w_up, w_down, ln_moe_w, Wgu8, Wd8, lane); moe_load(ma, ga, va); __builtin_amdgcn_sched_barrier(0); \
                    moe_store(mb, gb, vb); \
                } \
                moe_decode(mb, r_ + (step), w_gate, w_up, w_down, ln_moe_w, Wgu8, Wd8, lane); moe_load(mb, gb, vb); __builtin_amdgcn_sched_barrier(0); \
                moe_store(ma, ga, va); moe_store(mb, gb, vb); \
            } \
            P0_RUN(P0_DECODE_MOE, (first) + 2 * npair_ * (step), (step), (end)); \
        } while (0)
    constexpr int P1_IPW = 4;
    const int p1rem = 1216 % G, p1idle_w = p1rem ? (G - p1rem) * NWAVES : 0;
    const int NA = p1idle_w * P1_IPW < NMOE ? p1idle_w * P1_IPW : NMOE;
    if (IN(0)) { KPTRS
        const int lane = fresh_tid() & 63;
        P0_RUN(P0_DECODE_MAIN, gw, NGW, NMAIN);
        for (int idx = bx * 512 + tid; idx < 48 * 1024; idx += G * 512) {
            const int row = idx >> 10, k = idx & 1023, rr = row & 15, fq4 = rr >> 2, reg = rr & 3;
            const float wv = (row < 16 ? w_group[k * 4 + (row & 3)] : w_expert[k * 32 + 8 * fq4 + (row >= 32 ? 4 : 0) + reg]) * ln_moe_w[k];
            const bf16_t hb = f2bf(wv);
            WrT[idx] = hb; WrT[48 * 1024 + idx] = f2bf(wv - bf2f(hb));
        }
        {
            pg8::f32x4 vc[2][4], vn[2][4];
#define P0_XLOAD(V, row2) do { _Pragma("unroll") for (int h2 = 0; h2 < 2; ++h2) { const int row = (row2) * 2 + h2; const float* src = row < NTOK ? x + (size_t)row * DM : mem + (size_t)(row - NTOK) * DM; \
                _Pragma("unroll") for (int i = 0; i < 4; ++i) V[h2][i] = __builtin_nontemporal_load(&((const pg8::f32x4*)src)[lane + 64 * i]); } } while (0)
            if (gw < (NTOK + NMEM) / 2) P0_XLOAD(vc, gw);
            for (int row2 = gw; row2 < (NTOK + NMEM) / 2; row2 += NGW) {
                const bool has_next = row2 + NGW < (NTOK + NMEM) / 2;
                if (has_next) P0_XLOAD(vn, row2 + NGW);
#pragma unroll
                for (int h2 = 0; h2 < 2; ++h2) { const int row = row2 * 2 + h2; float ss = 0.f;
#pragma unroll
                    for (int i = 0; i < 4; ++i) { const pg8::f32x4 t = vc[h2][i]; ss += (t[0] * t[0] + t[1] * t[1]) + (t[2] * t[2] + t[3] * t[3]);
                        uint2 o; o.x = pk2rn(t[0], t[1]); o.y = pk2rn(t[2], t[3]); ((uint2*)(xb + (size_t)row * DM))[lane + 64 * i] = o; }
                    ss = wave_sum(ss);
                    if (lane == 0) { const float rs = rsqrtf(ss * (1.0f / DM) + EPS); if (row < NTOK) rstd0[row] = rs; else rstdm[row - NTOK] = rs; } }
                if (has_next) {
#pragma unroll
                    for (int h2 = 0; h2 < 2; ++h2)
#pragma unroll
                        for (int i = 0; i < 4; ++i) vc[h2][i] = vn[h2][i]; }
            }
#undef P0_XLOAD
        }
        for (int idx = bx * 512 + tid; idx < NTOK * 32; idx += G * 512) {
            const int row = idx >> 5, i = idx & 31;
            const double inv_freq = exp(-9.210340371976184 * (double)(2 * i) / 64.0);
            const double rev = (double)positions[row] * inv_freq * 0.15915494309189535;
            const float fr = (float)(rev - floor(rev));
            ((unsigned*)ropet)[idx] = (unsigned)f2bf(__builtin_amdgcn_cosf(fr)) | ((unsigned)f2bf(__builtin_amdgcn_sinf(fr)) << 16);
        }
    }
    SEAM(0);
    if (lo == 0 && hi == 11) {
        volatile LAS unsigned* st = (volatile LAS unsigned*)(lds + LX_BAR);
        if (tid == 0) { bool ok = (G % 8 == 0) && bar.x < 8u;
            for (unsigned j = 0; j < 16; ++j) { const unsigned c = xb_ld(&bar.bar[XB_XCNT(j)]); ok = ok && (c == (j < 8u ? (unsigned)G / 8u : 0u)); }
            st[3] = ok ? 1u : 0u; }
        __syncthreads();
        xl = __builtin_amdgcn_readfirstlane(st[3]) != 0u;
        if (xl) { bx = (int)(__builtin_amdgcn_readfirstlane(st[2]) * 8u + bar.x); gw = bx * NWAVES + wave; }
    }
    if (IN(1)) { KPTRS
        pg8::Gemm g{xb, WinT, NTOK + NMEM, 2304 + 2048, 1024}; pg8::InProjOrder S{G, bx};
        LAS float* rst = (LAS float*)(lds + LX_RST);
        { pg8::Unit u; float tv[MOE_MAXU]; bool ok[MOE_MAXU];
#pragma unroll
          for (int i = 0; i < MOE_MAXU; ++i) { ok[i] = S.next(i, u) && tid < 256; tv[i] = ok[i] ? rstd0[u.pm * 256 + tid] : 0.f; }
#pragma unroll
          for (int i = 0; i < MOE_MAXU; ++i) if (ok[i]) rst[i * 256 + tid] = tv[i];
          __syncthreads(); }
        pg8::EpiInProj E{projr, kvc, rst, (const unsigned*)ropet};
        pg8::gemm_phase<pg8::EpiInProj, pg8::InProjOrder, true, true, false>(lds, g, S, E);
        if (p1rem && bx >= p1rem) { KPTRS const int lane = fresh_tid() & 63; const int first = (bx - p1rem) * NWAVES + wave; MOE_RUN(first, p1idle_w, NA); }
    }
    LSEAM(1);
    if (IN(2)) { KPTRS
        const float* lq1 = KGP(const float, kp_[5]); const float* lk1 = KGP(const float, kp_[6]); const float* lq2 = KGP(const float, kp_[7]); const float* lk2 = KGP(const float, kp_[8]);
        const float* subln_w = KGP(const float, kp_[9]); const float* sinks = KGP(const float, kp_[10]);
        const int lane = fresh_tid() & 63;
        const float a1 = wave_sum(lq1[lane] * lk1[lane]), a2 = wave_sum(lq2[lane] * lk2[lane]);
        const float lam = __uint_as_float(__builtin_amdgcn_readfirstlane(__float_as_uint(expf(a1) - expf(a2) + LAMBDA_INIT)));
        const int vcu = (G % 8 == 0) ? (bx % 8) * (G / 8) + bx / 8 : bx;
        const int nb4 = 1;
        int L = vcu, nun = 0;
        for (; L < 1024 && nun < nb4; L += G, ++nun) {
            const int v = L & 255, bh = v >> 3, s = v & 7, i = ((L >> 8) + bh) & 3, qb = (i == 0) ? s : (i == 1) ? 15 - s : (i == 2) ? 16 + s : 31 - s;
            att::diff_unit(lds, projr, ocat, bh >> 2, bh & 3, qb, lam, subln_w);
        }
        { const int lane2 = fresh_tid() & 63; { KPTRS const int lane = lane2; MOE_RUN(NA + gw, NGW, NMOE); } }
        for (; L < 1024; L += G) {
            const int v = L & 255, bh = v >> 3, s = v & 7, i = ((L >> 8) + bh) & 3, qb = (i == 0) ? s : (i == 1) ? 15 - s : (i == 2) ? 16 + s : 31 - s;
            att::diff_unit(lds, projr, ocat, bh >> 2, bh & 3, qb, lam, subln_w);
        }
        __syncthreads();
        att::swa_phase(lds, projr, ocat, sinks, vcu, G, 1024, [](int L, int& b_, int& h_, int& j_) { const int u_ = (L & 31) + 32 * (L >> 8); b_ = (L & 255) >> 5; h_ = u_ >> 6; j_ = u_ & 63; });
    }
    LSEAM(2);
    if (IN(3)) { KPTRS
        pg8::Gemm g{ocat, WoutT, NTOK, 1024, 512}; pg8::StaticOrder S; S.init(NTOK, 1024, G, bx);
        pg8::EpiRes E{xb, h1b, ssp1, h1q, 1.0f / 1024.0f, OCP};
        pg8::gemm_phase<pg8::EpiRes, pg8::StaticOrder, true, true, false, true>(lds, g, S, E);
    }
    LSEAM(3);
    if (IN(4)) { KPTRS
        pg8::Gemm g{(const bf16_t*)h1q, (const bf16_t*)Wq8, NTOK, 1024, 512, OCP / 2}; pg8::StaticOrderUi S; S.init(NTOK, 1024, G, bx);
        LAS float* rst = (LAS float*)(lds + LX_RST);
        { pg8::Unit u;
#pragma unroll
          for (int i = 0; i < 2; ++i) if (S.next(i, u) && tid < 256) rst[i * 256 + tid] = pg8::rstd_from_ssp(ssp1, u.pm * 256 + tid) * (C2_CROSS / 64.0f);
          { pg8::Unit u2; if (S.next(2, u2)) for (int i = 2; i < MOE_MAXU && S.next(i, u2); ++i) if (tid < 256) rst[i * 256 + tid] = pg8::rstd_from_ssp(ssp1, u2.pm * 256 + tid) * (C2_CROSS / 64.0f); }
          __syncthreads(); }
        pg8::EpiScale E{qc, rst};
        pg8::gemm_phase<pg8::EpiScale, pg8::StaticOrderUi, true, true, false, true>(lds, g, S, E);
    }
    if (IN(4) && IN(5)) {
        asm volatile("s_waitcnt vmcnt(0)" ::: "memory"); __syncthreads();
        __builtin_amdgcn_fence(__ATOMIC_ACQUIRE, "agent"); asm volatile("s_waitcnt vmcnt(0)" ::: "memory"); __syncthreads();
    }
    if (IN(5)) { KPTRS
        pg8::StaticOrder S; S.init(NTOK, 1024, G, bx);
        att::cross_phase(lds, qc, kvc, oc8, OCP, S);
    }
    LSEAM(5);
    if (IN(6)) { KPTRS
        pg8::Gemm g{(const bf16_t*)oc8, (const bf16_t*)Woc8, NTOK, 1024, 512, OCP / 2}; pg8::StaticOrder S; S.init(NTOK, 1024, G, bx);
        pg8::EpiRes E{h1b, h2b, ssp2, h2q, 1.0f / 1024.0f, 1024};
        pg8::gemm_phase<pg8::EpiRes, pg8::StaticOrder, true, true, false, true>(lds, g, S, E);
    }
    LSEAM(6);
    if (IN(7)) { KPTRS
        LAS float* part = (LAS float*)lds; LAS int* lcnt = (LAS int*)(lds + 98304); LAS int* gbase = lcnt + 32;
        const int lane = fresh_tid() & 63;
        const int fq = lane >> 4;
        for (int blk0 = bx; blk0 < NTOK / 128; blk0 += G) {
            const int blk = (G % 8 == 0 && NTOK / 128 == G) ? (blk0 % 8) * (G / 8) + blk0 / 8 : blk0;
            if (tid < 32) lcnt[tid] = 0;
            pg8::bf16x8 wf[3][2][4];
            { const bf16_t* wh = WrT + (size_t)(lane & 15) * 1024 + 128 * wave + 8 * fq;
#pragma unroll
              for (int j = 0; j < 3; ++j)
#pragma unroll
                  for (int p = 0; p < 2; ++p)
#pragma unroll
                      for (int s = 0; s < 4; ++s) wf[j][p][s] = *(const pg8::bf16x8*)(wh + p * 49152 + j * 16384 + 32 * s); }
            int e0r[2], e1r[2], li0[2], li1[2]; float g0r[2], g1r[2], rsr[2]; bool actr[2];
            pg8::bf16x8 afA[2][4], afB[2][4];
#pragma unroll
            for (int r = 0; r < 2; ++r) {
#define RT_LOAD(A, q2) do { const int _q2 = (q2) < 4 ? (q2) : 3; _Pragma("unroll") for (int g2 = 0; g2 < 2; ++g2) { const bf16_t* _ap = h2b + (size_t)(blk * 128 + (2 * _q2 + g2) * 16 + (lane & 15)) * DM + 128 * wave + 8 * fq; \
                    _Pragma("unroll") for (int s = 0; s < 4; ++s) A[g2][s] = *(const pg8::bf16x8*)(_ap + 32 * s); } } while (0)
#define RT_HALF(A, glb) do { _Pragma("unroll") for (int g2 = 0; g2 < 2; ++g2) { pg8::f32x4 acc[3]; \
                    _Pragma("unroll") for (int j = 0; j < 3; ++j) acc[j] = (pg8::f32x4){0.f, 0.f, 0.f, 0.f}; \
                    _Pragma("unroll") for (int s = 0; s < 4; ++s) { \
                        _Pragma("unroll") for (int j = 0; j < 3; ++j) { acc[j] = __builtin_amdgcn_mfma_f32_16x16x32_bf16(wf[j][0][s], A[g2][s], acc[j], 0, 0, 0); acc[j] = __builtin_amdgcn_mfma_f32_16x16x32_bf16(wf[j][1][s], A[g2][s], acc[j], 0, 0, 0); } } \
                    _Pragma("unroll") for (int j = 0; j < 3; ++j) \
                        _Pragma("unroll") for (int c = 0; c < 4; ++c) part[((wave * 4 + (glb) + g2) * 12 + j * 4 + c) * 64 + lane] = acc[j][c]; } } while (0)
                if (r == 0) { RT_LOAD(afA, 0); __builtin_amdgcn_sched_barrier(0); }
                RT_LOAD(afB, 2 * r + 1); __builtin_amdgcn_sched_barrier(0);
                RT_HALF(afA, 0); __builtin_amdgcn_sched_barrier(0);
                RT_LOAD(afA, 2 * r + 2); __builtin_amdgcn_sched_barrier(0);
                RT_HALF(afB, 2); __builtin_amdgcn_sched_barrier(0);
#undef RT_LOAD
#undef RT_HALF
                __syncthreads();
                actr[r] = false; e0r[r] = 0; e1r[r] = 0; li0[r] = 0; li1[r] = 0; g0r[r] = 0.f; g1r[r] = 0.f; rsr[r] = 0.f;
                if (wave < 4) {
                    float v[12];
#pragma unroll
                    for (int q = 0; q < 12; ++q) v[q] = 0.f;
#pragma unroll 1
                    for (int ww = 0; ww < 8; ++ww) {
#pragma unroll
                        for (int q = 0; q < 12; ++q) v[q] += part[((ww * 4 + wave) * 12 + q) * 64 + lane]; }
                    const int tok = blk * 128 + (4 * r + wave) * 16 + (lane & 15);
                    const float rs = pg8::rstd_from_ssp(ssp2, tok);
                    float lg[4], el[8];
#pragma unroll
                    for (int j = 0; j < 4; ++j) { lg[j] = v[j] * rs + b_group[j]; el[j] = v[4 + j] * rs + b_expert[8 * fq + j]; el[4 + j] = v[8 + j] * rs + b_expert[8 * fq + 4 + j]; }
                    int gs = 0; float gm = lg[0];
#pragma unroll
                    for (int j = 1; j < 4; ++j) if (lg[j] > gm) { gm = lg[j]; gs = j; }
                    float gden = 0.f;
#pragma unroll
                    for (int j = 0; j < 4; ++j) gden += expf(lg[j] - gm);
                    const float gp = 1.0f / gden;
                    int i0 = 0; float v0 = el[0];
#pragma unroll
                    for (int j = 1; j < 8; ++j) if (el[j] > v0) { v0 = el[j]; i0 = j; }
                    int i1 = (i0 == 0) ? 1 : 0; float v1 = -INFINITY;
#pragma unroll
                    for (int j = 0; j < 8; ++j) if (j != i0 && el[j] > v1) { v1 = el[j]; i1 = j; }
                    const float w0 = 1.0f / (1.0f + expf(v1 - v0));
                    if (fq == gs) {
                        actr[r] = true; e0r[r] = gs * 8 + i0; e1r[r] = gs * 8 + i1; g0r[r] = gp * w0; g1r[r] = gp * (1.0f - w0); rsr[r] = rs;
                        li0[r] = __hip_atomic_fetch_add(lcnt + e0r[r], 1, __ATOMIC_RELAXED, __HIP_MEMORY_SCOPE_WORKGROUP);
                        li1[r] = __hip_atomic_fetch_add(lcnt + e1r[r], 1, __ATOMIC_RELAXED, __HIP_MEMORY_SCOPE_WORKGROUP);
                    }
                }
                __syncthreads();
            }
            if (tid < 32) gbase[tid] = atomicAdd(&counts[tid], lcnt[tid]);
            __syncthreads();
            if (wave < 4) {
#pragma unroll
                for (int r = 0; r < 2; ++r) if (actr[r]) {
                    const int tok = blk * 128 + (4 * r + wave) * 16 + (lane & 15);
                    const int e0 = e0r[r], e1 = e1r[r], x0 = gbase[e0] + li0[r], x1 = gbase[e1] + li1[r];
                    explist[(size_t)e0 * NTOK + x0] = tok; explist[(size_t)e1 * NTOK + x1] = tok;
                    tok_e[tok * 2] = e0; tok_e[tok * 2 + 1] = e1; tok_i[tok * 2] = x0; tok_i[tok * 2 + 1] = x1;
                    tok_g[tok * 2] = g0r[r]; tok_g[tok * 2 + 1] = g1r[r];
                    rstd2[tok] = rsr[r];
                }
            }
            __syncthreads();
        }
    }
    SEAM(7);
    if (IN(8) || IN(9)) { KPTRS
        LAS int* pst = (LAS int*)(lds + LX_PST);
        if (tid == 0) { int s = 0; for (int e = 0; e < 32; ++e) { pst[e] = s; s += (counts[e] + 255) >> 8; } pst[32] = s; }
        __syncthreads();
    }
    if (IN(8)) { KPTRS
        LAS int* pst = (LAS int*)(lds + LX_PST); LAS int* tokt = (LAS int*)(lds + LX_TOK); LAS float* rst = (LAS float*)(lds + LX_RST);
        pg8::MoeOrderX S{G, bx, pst[32], pst, tokt, false, nullptr, false};
        {
            pg8::Unit u; int tk[MOE_MAXU]; float tr[MOE_MAXU]; bool ok[MOE_MAXU];
#pragma unroll
            for (int i = 0; i < MOE_MAXU; ++i) { ok[i] = S.next(i, u) && tid < 256; tk[i] = 0;
                if (ok[i]) { const int e = u.pn >> 2, idx = (u.pm - pst[e]) * 256 + tid, cnt = counts[e]; tk[i] = explist[(size_t)e * NTOK + (idx < cnt ? idx : 0)]; } }
#pragma unroll
            for (int i = 0; i < MOE_MAXU; ++i) tr[i] = ok[i] ? rstd2[tk[i]] : 0.f;
#pragma unroll
            for (int i = 0; i < MOE_MAXU; ++i) if (ok[i]) { tokt[i * 256 + tid] = tk[i]; rst[i * 256 + tid] = tr[i]; }
            __syncthreads();
        }
        pg8::Gemm g{(const bf16_t*)h2q, (const bf16_t*)Wgu8, PMAX, 32 * 1024, 512};
        pg8::EpiGateUp E{hdn8, rst};
        pg8::gemm_phase<pg8::EpiGateUp, pg8::MoeOrderX, true, true, true, true>(lds, g, S, E);
    }
    LSEAM(8);
    if (IN(9)) { KPTRS
        LAS int* pst = (LAS int*)(lds + LX_PST);
        pg8::MoeOrderX S{G, bx, pst[32], pst, (LAS int*)(lds + LX_TOK), true, nullptr, true};
        pg8::Gemm g{(const bf16_t*)hdn8, (const bf16_t*)Wd8, PMAX, 32 * 1024, 256};
        pg8::EpiDown E{y8};
        pg8::gemm_phase<pg8::EpiDown, pg8::MoeOrderX, true, true, false, true>(lds, g, S, E);
    }
    SEAM(9);
    if (IN(10)) { KPTRS
        const int lane = fresh_tid() & 63;
        LAS int* sb = (LAS int*)(lds + LX_PST);
        __syncthreads();
        if (tid == 0) { int s = 0; for (int e = 0; e < 32; ++e) { sb[e] = s; s += (counts[e] + 255) & ~255; } }
        __syncthreads();
        struct Meta { int e0, e1, i0, i1; float g0, g1; };
#define P10_META(M, tok) do { const int2 _e = *(const int2*)(tok_e + (tok) * 2), _i = *(const int2*)(tok_i + (tok) * 2); const float2 _g = *(const float2*)(tok_g + (tok) * 2); \
            M.e0 = _e.x; M.e1 = _e.y; M.i0 = _i.x; M.i1 = _i.y; M.g0 = _g.x; M.g1 = _g.y; } while (0)
#define P10_ROWS(A, B, C, M, tok) do { const size_t _s0 = (size_t)(sb[M.e0] + M.i0), _s1 = (size_t)(sb[M.e1] + M.i1); \
            _Pragma("unroll") for (int i = 0; i < 4; ++i) { A[i] = ((const ushort4*)(h2b + (size_t)(tok) * DM))[lane + 64 * i]; B[i] = ((const unsigned*)(y8 + _s0 * DM))[lane + 64 * i]; C[i] = ((const unsigned*)(y8 + _s1 * DM))[lane + 64 * i]; } } while (0)
        Meta m0, m1, m2; ushort4 ac[4], an[4]; unsigned bc[4], cc[4], bn[4], cn[4];
        m0 = Meta{0, 0, 0, 0, 0.f, 0.f}; m1 = m0; m2 = m0;
        if (gw < NTOK) { P10_META(m0, gw); if (gw + NGW < NTOK) P10_META(m1, gw + NGW); P10_ROWS(ac, bc, cc, m0, gw); }
        for (int tok = gw; tok < NTOK; tok += NGW) {
            const bool has1 = tok + NGW < NTOK, has2 = tok + 2 * NGW < NTOK;
            if (has2) P10_META(m2, tok + 2 * NGW);
            if (has1) P10_ROWS(an, bn, cn, m1, tok + NGW);
            const float g0 = m0.g0 * (1.0f / 16.0f), g1 = m0.g1 * (1.0f / 16.0f);
            float v[16]; float ss = 0.f;
#pragma unroll
            for (int i = 0; i < 4; ++i) {
                const ushort4 a = ac[i]; const int b = (int)bc[i], c = (int)cc[i];
                v[4 * i + 0] = bf2f(a.x) + g0 * __builtin_amdgcn_cvt_f32_fp8(b, 0) + g1 * __builtin_amdgcn_cvt_f32_fp8(c, 0);
                v[4 * i + 1] = bf2f(a.y) + g0 * __builtin_amdgcn_cvt_f32_fp8(b, 1) + g1 * __builtin_amdgcn_cvt_f32_fp8(c, 1);
                v[4 * i + 2] = bf2f(a.z) + g0 * __builtin_amdgcn_cvt_f32_fp8(b, 2) + g1 * __builtin_amdgcn_cvt_f32_fp8(c, 2);
                v[4 * i + 3] = bf2f(a.w) + g0 * __builtin_amdgcn_cvt_f32_fp8(b, 3) + g1 * __builtin_amdgcn_cvt_f32_fp8(c, 3);
#pragma unroll
                for (int j = 0; j < 4; ++j) ss += v[4 * i + j] * v[4 * i + j];
            }
            ss = wave_sum(ss);
            const float rs = rsqrtf(ss * (1.0f / DM) + EPS);
#pragma unroll
            for (int i = 0; i < 4; ++i) {
                const float4 w = ((const float4*)ln_final_w)[lane + 64 * i];
                float4 o; o.x = v[4 * i] * rs * w.x; o.y = v[4 * i + 1] * rs * w.y; o.z = v[4 * i + 2] * rs * w.z; o.w = v[4 * i + 3] * rs * w.w;
                { pg8::f32x4 o4; o4[0] = o.x; o4[1] = o.y; o4[2] = o.z; o4[3] = o.w; __builtin_nontemporal_store(o4, &((pg8::f32x4*)(out_ + (size_t)tok * DM))[lane + 64 * i]); }
            }
            m0 = m1; m1 = m2;
#pragma unroll
            for (int i = 0; i < 4; ++i) { ac[i] = an[i]; bc[i] = bn[i]; cc[i] = cn[i]; }
        }
#undef P10_META
#undef P10_ROWS
    }
#undef IN
#undef SEAM
}

static void launch_mk(hipStream_t st, int grid, const MkArgs& base, int lo, int hi, int li) {
    MkArgs a = base; a.ph_lo = lo; a.ph_hi = hi; a.li = li; a.pad = 0;
    hipLaunchKernelGGL(mk_fwd, dim3(grid), dim3(NWAVES * 64), LDS_BYTES, st, a);
}

extern "C" void kernel_launch(void* const* d_in, const int* in_sizes, int n_in, void* d_out, int out_size, void* d_ws, size_t ws_size, hipStream_t stream) {
    (void)in_sizes; (void)n_in; (void)out_size; (void)ws_size;
    static int grid = 0;
    if (grid == 0) {
        int dev = 0, cus = 0, per_cu = 0;
        (void)hipGetDevice(&dev);
        (void)hipDeviceGetAttribute(&cus, hipDeviceAttributeMultiprocessorCount, dev);
        (void)hipFuncSetAttribute((const void*)mk_fwd, hipFuncAttributeMaxDynamicSharedMemorySize, LDS_BYTES);
        (void)hipOccupancyMaxActiveBlocksPerMultiprocessor(&per_cu, (const void*)mk_fwd, NWAVES * 64, LDS_BYTES);
        (void)hipGetLastError();
        grid = cus > 0 ? cus : 256;
    }
    char* ws = (char*)d_ws;

    (void)hipMemsetAsync(ws + WS_CTL, 0, CTL_BYTES, stream);
    MkArgs a; memset(&a, 0, sizeof(a));
    for (int i = 0; i < 26; ++i) a.in[i] = (const float*)d_in[i];
    a.out = (float*)d_out; a.ws = (unsigned char*)d_ws;
    launch_mk(stream, grid, a, 0, 11, 0);
}
```
